# Optimizing an MI355X kernel written in HIP

```python
import jax
import jax.numpy as jnp
from jax import lax
import numpy as np

D_MODEL = 1024
BATCH = 2
SEQ = 16384
DEPTH = 2

CTX_LEN = 256
GRID_W = 64
HG_HEADS = 4
HG_DK = 128
HG_DV = 128
HG_WIDTH = HG_HEADS * HG_DK
HG_CHUNK = 64
RG_WIDTH = 512
RG_BLOCKS = 8
RG_BLOCK = RG_WIDTH // RG_BLOCKS
RG_CONV = 4
RG_C = 8.0
MIX_WIDTH = HG_WIDTH + RG_WIDTH
IN_COLS = 5 * HG_WIDTH + 2 * RG_WIDTH
D_FF = -(-8 * D_MODEL // (3 * 256)) * 256
N_MOD = 6
EPS = 1e-6

kernel_name = 'hybrid_hgrn2_rglru_prefix_dit_block'


def rms_norm(x, w):
    xf = x.astype(jnp.float32)
    y = xf * lax.rsqrt(jnp.mean(xf * xf, axis=-1, keepdims=True) + EPS)
    return (y * w.astype(jnp.float32)).astype(x.dtype)


def split_heads(a):
    b, t, _ = a.shape
    return a.reshape(b, t, HG_HEADS, -1).transpose(0, 2, 1, 3)


def merge_heads(a):
    b, h, t, d = a.shape
    return a.transpose(0, 2, 1, 3).reshape(b, t, h * d)


def flip_time(a, reverse, axis):
    return jnp.flip(a, axis=axis) if reverse else a


def hgrn2_gates(z, lb):
    lb = lb[None, :, None, :]
    log_f = jnp.log(lb + (1.0 - lb) * jax.nn.sigmoid(z))
    k = (1.0 - lb) * jax.nn.sigmoid(-z)
    return log_f, k


def hgrn2_chunk_scan(q, k, v, log_f, s0):
    b, h, t, _ = q.shape
    n = t // HG_CHUNK

    def chunks(a):
        return jnp.moveaxis(a.reshape(b, h, n, HG_CHUNK, a.shape[-1]), 2, 0)

    lower_tri = jnp.tril(jnp.ones((HG_CHUNK, HG_CHUNK), dtype=bool))[:, :, None]

    def step(s, inp):
        qc, kc, vc, lc = inp
        cum = jnp.cumsum(lc, axis=2)
        diff = cum[:, :, :, None, :] - cum[:, :, None, :, :]
        decay = jnp.exp(jnp.where(lower_tri, diff, -jnp.inf))
        scores = jnp.einsum('bhtk,bhtsk,bhsk->bhts', qc, decay, kc)
        o = (jnp.einsum('bhts,bhsv->bhtv', scores, vc)
             + jnp.einsum('bhtk,bhkv->bhtv', qc * jnp.exp(cum), s))
        total = cum[:, :, -1:, :]
        s_new = (jnp.exp(total[:, :, 0, :, None]) * s
                 + jnp.einsum('bhsk,bhsv->bhkv', kc * jnp.exp(total - cum), vc))
        return s_new, o

    s_fin, o = lax.scan(step, s0, (chunks(q), chunks(k), chunks(v), chunks(log_f)))
    return jnp.moveaxis(o, 0, 2).reshape(b, h, t, -1), s_fin


def hgrn2_mixer(p_ctx, p_lat, lb, g_norm_w, with_ctx_out):
    def parts(p):
        q, zf, zb, v, g = jnp.split(p[..., :5 * HG_WIDTH].astype(jnp.float32), 5, axis=-1)
        return jax.nn.silu(split_heads(q)), (split_heads(zf), split_heads(zb)), split_heads(v), g

    q_c, z_c, v_c, g_c = parts(p_ctx)
    q_l, z_l, v_l, g_l = parts(p_lat)
    s0 = jnp.zeros((q_c.shape[0], HG_HEADS, HG_DK, HG_DV), jnp.float32)
    outs_c, outs_l = [], []
    for d in range(2):
        rev = d == 1
        lb_d = lb[d].astype(jnp.float32).reshape(HG_HEADS, HG_DK)
        lf_c, k_c = hgrn2_gates(z_c[d], lb_d)
        lf_l, k_l = hgrn2_gates(z_l[d], lb_d)
        o_c, s_ctx = hgrn2_chunk_scan(*(flip_time(a, rev, 2) for a in (q_c, k_c, v_c, lf_c)), s0)
        o_l, _ = hgrn2_chunk_scan(*(flip_time(a, rev, 2) for a in (q_l, k_l, v_l, lf_l)), s_ctx)
        outs_c.append(flip_time(o_c, rev, 2))
        outs_l.append(flip_time(o_l, rev, 2))

    def readout(o, g):
        return merge_heads(rms_norm(o, g_norm_w)) * jax.nn.silu(g)

    out_l = readout(outs_l[0] + outs_l[1], g_l).astype(p_lat.dtype)
    out_c = readout(outs_c[0] + outs_c[1], g_c).astype(p_ctx.dtype) if with_ctx_out else None
    return out_c, out_l


def depthwise_conv(u, w, bias):
    pad_l = RG_CONV // 2
    out = lax.conv_general_dilated(
        u, w[:, None, :], window_strides=(1,), padding=[(pad_l, RG_CONV - 1 - pad_l)],
        dimension_numbers=('NWC', 'WIO', 'NWC'), feature_group_count=u.shape[-1])
    return out + bias


def rglru_coeffs(u, w_a, b_a, w_x, b_x, lam):
    ub = u.reshape(*u.shape[:-1], RG_BLOCKS, RG_BLOCK)
    r = jax.nn.sigmoid(jnp.einsum('btni,nij->btnj', ub, w_a).reshape(u.shape) + b_a)
    i = jax.nn.sigmoid(jnp.einsum('btni,nij->btnj', ub, w_x).reshape(u.shape) + b_x)
    log_a = RG_C * r * jax.nn.log_sigmoid(lam)
    return jnp.exp(log_a), jnp.sqrt(-jnp.expm1(2.0 * log_a)) * (i * u)


def linear_recurrence(a, bx, h0):
    def combine(e1, e2):
        return e1[0] * e2[0], e2[0] * e1[1] + e2[1]
    a_cum, h = lax.associative_scan(combine, (a, bx), axis=1)
    return h + a_cum * h0[:, None, :]


def rglru_mixer(p_ctx, p_lat, conv_w, conv_b, w_a, b_a, w_x, b_x, lam, with_ctx_out):
    f32 = jnp.float32
    conv_w, conv_b = conv_w.astype(f32), conv_b.astype(f32)
    u_c, gate_c = jnp.split(p_ctx[..., 5 * HG_WIDTH:].astype(f32), 2, axis=-1)
    u_l, gate_l = jnp.split(p_lat[..., 5 * HG_WIDTH:].astype(f32), 2, axis=-1)
    b, n_lat, ch = u_l.shape
    rows = n_lat // GRID_W
    u_c = depthwise_conv(u_c, conv_w, conv_b)
    u_l = depthwise_conv(u_l.reshape(b * rows, GRID_W, ch), conv_w, conv_b).reshape(b, n_lat, ch)
    h0 = jnp.zeros((b, ch), f32)
    hs_c, hs_l = [], []
    for d in range(2):
        rev = d == 1
        prm = (w_a[d].astype(f32), b_a[d].astype(f32), w_x[d].astype(f32), b_x[d].astype(f32), lam[d].astype(f32))
        a_c, x_c = rglru_coeffs(flip_time(u_c, rev, 1), *prm)
        a_l, x_l = rglru_coeffs(flip_time(u_l, rev, 1), *prm)
        h_c = linear_recurrence(a_c, x_c, h0)
        h_l = linear_recurrence(a_l, x_l, h_c[:, -1])
        hs_c.append(flip_time(h_c, rev, 1))
        hs_l.append(flip_time(h_l, rev, 1))
    out_l = ((hs_l[0] + hs_l[1]) * jax.nn.gelu(gate_l)).astype(p_lat.dtype)
    out_c = ((hs_c[0] + hs_c[1]) * jax.nn.gelu(gate_c)).astype(p_ctx.dtype) if with_ctx_out else None
    return out_c, out_l


def swiglu(h, w_gate, w_up, w_down):
    return (jax.nn.silu(h @ w_gate) * (h @ w_up)) @ w_down


def setup_inputs(seed: int = 0) -> dict:
    key = jax.random.key(seed)
    ks = jax.random.split(key, 24)

    def nrm(k, shape, scale):
        return scale * jax.random.normal(k, shape, jnp.float32)

    a0 = jax.random.uniform(ks[16], (DEPTH, 2, RG_WIDTH), jnp.float32, 0.9, 0.999)
    s = a0 ** (1.0 / RG_C)
    return {
        'x': nrm(ks[0], (BATCH, SEQ, D_MODEL), 1.0),
        'c': nrm(ks[1], (BATCH, D_MODEL), 1.0),
        'ctx': nrm(ks[2], (BATCH, CTX_LEN, D_MODEL), 1.0),
        'c_ctx': nrm(ks[3], (D_MODEL,), 1.0),
        'w_mod': nrm(ks[4], (DEPTH, D_MODEL, N_MOD * D_MODEL), 0.5 * D_MODEL ** -0.5),
        'b_mod': nrm(ks[5], (DEPTH, N_MOD * D_MODEL), 0.02),
        'norm_g': 1.0 + nrm(ks[6], (DEPTH, 4, D_MODEL), 0.02),
        'w_in': nrm(ks[7], (DEPTH, D_MODEL, IN_COLS), D_MODEL ** -0.5),
        'hg_lb_logits': nrm(ks[8], (DEPTH, 2, HG_WIDTH), 1.0),
        'hg_gnorm': 1.0 + nrm(ks[9], (DEPTH, HG_DV), 0.02),
        'rg_conv_w': nrm(ks[10], (DEPTH, RG_CONV, RG_WIDTH), RG_CONV ** -0.5),
        'rg_conv_b': nrm(ks[11], (DEPTH, RG_WIDTH), 0.02),
        'rg_w_a': nrm(ks[12], (DEPTH, 2, RG_BLOCKS, RG_BLOCK, RG_BLOCK), RG_BLOCK ** -0.5),
        'rg_b_a': nrm(ks[13], (DEPTH, 2, RG_WIDTH), 0.02),
        'rg_w_x': nrm(ks[14], (DEPTH, 2, RG_BLOCKS, RG_BLOCK, RG_BLOCK), RG_BLOCK ** -0.5),
        'rg_b_x': nrm(ks[15], (DEPTH, 2, RG_WIDTH), 0.02),
        'rg_lambda': jnp.log(s) - jnp.log1p(-s),
        'w_out': nrm(ks[17], (DEPTH, MIX_WIDTH, D_MODEL), MIX_WIDTH ** -0.5),
        'w_ffn_gate': nrm(ks[18], (DEPTH, D_MODEL, D_FF), D_MODEL ** -0.5),
        'w_ffn_up': nrm(ks[19], (DEPTH, D_MODEL, D_FF), D_MODEL ** -0.5),
        'w_ffn_down': nrm(ks[20], (DEPTH, D_FF, D_MODEL), D_FF ** -0.5),
    }


def reference(x, c, ctx, c_ctx, w_mod, b_mod, norm_g, w_in, hg_lb_logits, hg_gnorm,
              rg_conv_w, rg_conv_b, rg_w_a, rg_b_a, rg_w_x, rg_b_x, rg_lambda,
              w_out, w_ffn_gate, w_ffn_up, w_ffn_down):
    b = x.shape[0]
    lb_all = jnp.cumsum(jax.nn.softmax(hg_lb_logits.astype(jnp.float32), axis=0), axis=0)
    lb_all = lb_all - lb_all[0]
    x_lat, x_ctx = x, ctx
    for layer in range(DEPTH):
        with_ctx = layer < DEPTH - 1
        m_l = (jax.nn.silu(c) @ w_mod[layer] + b_mod[layer]).reshape(b, N_MOD, 1, D_MODEL)
        m_c = (jax.nn.silu(c_ctx) @ w_mod[layer] + b_mod[layer]).reshape(N_MOD, 1, 1, D_MODEL)
        g = norm_g[layer]
        h_l = rms_norm(x_lat, g[0]) * (1.0 + m_l[:, 1]) + m_l[:, 0]
        h_c = rms_norm(x_ctx, g[0]) * (1.0 + m_c[1]) + m_c[0]
        p_l = h_l @ w_in[layer]
        p_c = h_c @ w_in[layer]
        hg_c, hg_l = hgrn2_mixer(p_c, p_l, lb_all[layer], hg_gnorm[layer], with_ctx)
        rg_c, rg_l = rglru_mixer(p_c, p_l, rg_conv_w[layer], rg_conv_b[layer], rg_w_a[layer], rg_b_a[layer],
                                 rg_w_x[layer], rg_b_x[layer], rg_lambda[layer], with_ctx)
        o_l = jnp.concatenate([hg_l, rg_l], axis=-1) @ w_out[layer]
        x_lat = x_lat + m_l[:, 2] * rms_norm(o_l, g[1])
        f_l = rms_norm(x_lat, g[2]) * (1.0 + m_l[:, 4]) + m_l[:, 3]
        x_lat = x_lat + m_l[:, 5] * rms_norm(swiglu(f_l, w_ffn_gate[layer], w_ffn_up[layer], w_ffn_down[layer]), g[3])
        if with_ctx:
            o_c = jnp.concatenate([hg_c, rg_c], axis=-1) @ w_out[layer]
            x_ctx = x_ctx + m_c[2] * rms_norm(o_c, g[1])
            f_c = rms_norm(x_ctx, g[2]) * (1.0 + m_c[4]) + m_c[3]
            x_ctx = x_ctx + m_c[5] * rms_norm(swiglu(f_c, w_ffn_gate[layer], w_ffn_up[layer], w_ffn_down[layer]), g[3])
    return x_lat
```

```cpp
#include <hip/hip_runtime.h>
#include <hip/hip_cooperative_groups.h>
#include <cstdio>
namespace cg = cooperative_groups;
namespace pg8 {
#define PG8_LAS __attribute__((address_space(3)))
typedef unsigned short bf16_t;
typedef short bf16x8 __attribute__((ext_vector_type(8)));
typedef float f32x4 __attribute__((ext_vector_type(4)));
typedef unsigned u32x4 __attribute__((ext_vector_type(4)));
constexpr int BM = 256, BK = 64, HALF = 128, HTB = HALF * BK * 2  , STAGE_BYTES = 8 * HTB, NXCD = 8, WGM = 8;

__host__ __device__ __forceinline__ int lds_byte(int r, int c) { const int st = (r >> 4) * 2 + (c >> 5), rr = r & 15, cc = c & 31, ob = rr * 64 + cc * 2; return st * 1024 + (ob ^ (((ob >> 9) & 1) << 5)); }
__host__ __device__ __forceinline__ void stage_rc(int b, int& R, int& C) { const int st = b / 1024, sb = b % 1024, swz = sb ^ (((sb >> 9) & 1) << 5); R = (st >> 1) * 16 + swz / 64; C = (st & 1) * 32 + (swz % 64) / 2; }
__host__ __device__ __forceinline__ int perm32(int rho) { const int n = rho >> 4, i = rho & 15; return 8 * (i >> 2) + 4 * n + (i & 3); }

struct Unit { int pm, pn; };
struct Gemm { const bf16_t* A; const bf16_t* Bt; int M, N, K; };

struct StaticOrder {
    int nM, nN, nwg, G, c;
    __host__ __device__ void init(int M, int N, int G_, int c_) { nM = M / BM; nN = N / BM; nwg = nM * nN; G = G_; c = c_; }
    __host__ __device__ bool next(int i, Unit& u) const {
        const long L = (long)i * G + c; if (L >= nwg) return false;
        int wgid = (int)L; { const int q = nwg / NXCD, r = nwg % NXCD, xcd = wgid % NXCD, off = wgid / NXCD; wgid = (xcd < r ? xcd * (q + 1) : r * (q + 1) + (xcd - r) * q) + off; }
        const int nig = WGM * nN, gid = wgid / nig, fm = gid * WGM, gsz = (nM - fm) < WGM ? (nM - fm) : WGM;
        u.pm = fm + ((wgid % nig) % gsz); u.pn = (wgid % nig) / gsz; return true;
    }
    __device__ __forceinline__ void a_ready(const Unit&) const {}
    __device__ __forceinline__ void done(const Unit&) const {}
};
__device__ __forceinline__ unsigned cvt_pk_bf16(float lo, float hi) { unsigned r; asm volatile("v_cvt_pk_bf16_f32 %0, %1, %2" : "=v"(r) : "v"(lo), "v"(hi)); return r; }
typedef float f32x2 __attribute__((ext_vector_type(2)));
__device__ __forceinline__ f32x2 gelu_pk(f32x2 v) {
    const f32x2 av = __builtin_elementwise_abs(v), d = av * 0.2316418882f + 1.0f;
    f32x2 t; t.x = __builtin_amdgcn_rcpf(d.x); t.y = __builtin_amdgcn_rcpf(d.y);
    f32x2 q = t * 0.5307027145f + (-0.7265760135f); q = q * t + 0.7107068705f; q = q * t + (-0.142248368f); q = q * t + 0.127414796f; q = q * t;
    const f32x2 s = (v * v) * (-0.72134752044f);
    f32x2 e; e.x = __builtin_amdgcn_exp2f(s.x); e.y = __builtin_amdgcn_exp2f(s.y);
    const f32x2 m = v * (q * e), r = v - m;
    f32x2 o; o.x = v.x < 0.f ? m.x : r.x; o.y = v.y < 0.f ? m.y : r.y; return o;
}

struct EpiF32 {
    static constexpr bool PERM = false, AFTER_DRAIN = false;
    float* C; int ldc; const float* bias;
    __device__ __forceinline__ void operator()(const f32x4 (&acc)[2][2][4][2], const Unit& u, int wr, int wc, int fr, int fq) const {
        const int row0 = u.pm * BM + wr * 64 + fr, col0 = u.pn * BM + wc * 32 + 4 * fq;
        f32x4 bv[2][2];
#pragma unroll
        for (int bj = 0; bj < 2; ++bj)
#pragma unroll
            for (int n = 0; n < 2; ++n) bv[bj][n] = bias ? *(const f32x4*)(bias + col0 + bj * HALF + n * 16) : (f32x4){0.f, 0.f, 0.f, 0.f};
#pragma unroll
        for (int ai = 0; ai < 2; ++ai)
#pragma unroll
            for (int m = 0; m < 4; ++m) { float* rowp = C + (size_t)(row0 + ai * HALF + m * 16) * ldc + col0;
#pragma unroll
                for (int bj = 0; bj < 2; ++bj)
#pragma unroll
                    for (int n = 0; n < 2; ++n) *(f32x4*)(rowp + bj * HALF + n * 16) = acc[ai][bj][m][n] + bv[bj][n]; }
    }
};
template <int ACT  > struct EpiBf16 {
    static constexpr bool PERM = true, AFTER_DRAIN = false;
    bf16_t* O; int ldc; const float* bias; int split_cols; size_t split_stride;
    __device__ __forceinline__ void operator()(const f32x4 (&acc)[2][2][4][2], const Unit& u, int wr, int wc, int fr, int fq) const {
        const int row0 = u.pm * BM + wr * 64 + fr; int colt = u.pn * BM; bf16_t* base = O;
        if (split_cols) { const int t = colt / split_cols; base += (size_t)t * split_stride; colt -= t * split_cols; }
        const int col0 = colt + wc * 32 + 8 * fq, bcol0 = u.pn * BM + wc * 32 + 8 * fq;
        f32x4 bv[2][2];
#pragma unroll
        for (int bj = 0; bj < 2; ++bj)
#pragma unroll
            for (int n = 0; n < 2; ++n) bv[bj][n] = bias ? *(const f32x4*)(bias + bcol0 + bj * HALF + 4 * n) : (f32x4){0.f, 0.f, 0.f, 0.f};
#pragma unroll
        for (int ai = 0; ai < 2; ++ai)
#pragma unroll
            for (int m = 0; m < 4; ++m) { bf16_t* rowp = base + (size_t)(row0 + ai * HALF + m * 16) * ldc + col0;
#pragma unroll
                for (int bj = 0; bj < 2; ++bj) { f32x4 v0 = acc[ai][bj][m][0] + bv[bj][0], v1 = acc[ai][bj][m][1] + bv[bj][1];
                    if (ACT == 1) { f32x2 a = gelu_pk((f32x2){v0[0], v0[1]}), b = gelu_pk((f32x2){v0[2], v0[3]}), c = gelu_pk((f32x2){v1[0], v1[1]}), d = gelu_pk((f32x2){v1[2], v1[3]});
                        v0 = (f32x4){a.x, a.y, b.x, b.y}; v1 = (f32x4){c.x, c.y, d.x, d.y}; }
                    if (ACT == 2) {
#pragma unroll
                        for (int j = 0; j < 4; ++j) { v0[j] = 0.5f * v0[j] * (1.0f + erff(v0[j] * 0.70710678f)); v1[j] = 0.5f * v1[j] * (1.0f + erff(v1[j] * 0.70710678f)); } }
                    u32x4 w; w.x = cvt_pk_bf16(v0[0], v0[1]); w.y = cvt_pk_bf16(v0[2], v0[3]); w.z = cvt_pk_bf16(v1[0], v1[1]); w.w = cvt_pk_bf16(v1[2], v1[3]);
                    *(u32x4*)(rowp + bj * HALF) = w; } }
    }
};

template <class Epi, class Sched, bool STAMP = false>
__device__ __forceinline__ void gemm_phase(PG8_LAS unsigned char* lds, const Gemm g, const Sched& S, const Epi& E, unsigned long long* stamps) {
    const int tid = threadIdx.x, wid = __builtin_amdgcn_readfirstlane(tid >> 6), lane = tid & 63, wr = wid >> 2, wc = wid & 3, fr = lane & 15, fq = lane >> 4;
    const int K = g.K, nt = K / BK;
    int ts_lo = 0, ts_hi = 0, nts = 0; const unsigned long long rt_entry = STAMP ? (unsigned long long)wall_clock64() : 0ull;
#define PG8_STAMP() do { if (STAMP && wid == 0 && nts < 64) { const unsigned long long _c = (unsigned long long)clock64(); \
        ts_lo = (lane == nts) ? (int)(unsigned)_c : ts_lo; ts_hi = (lane == nts) ? (int)(unsigned)(_c >> 32) : ts_hi; ++nts; } } while (0)
    PG8_STAMP();
    unsigned voffA[2], voffB[2];
#pragma unroll
    for (int i = 0; i < 2; ++i) { int R, C; stage_rc(tid * 16 + i * 8192, R, C); const int Rb = Epi::PERM ? ((R & ~31) + perm32(R & 31)) : R;
        voffA[i] = (unsigned)(R * K + C) * 2u; voffB[i] = (unsigned)(Rb * K + C) * 2u; }
    const size_t kstep = (size_t)(BK * 2);
    const size_t hstep = (size_t)HALF * K * 2;
    const size_t tstep = 2 * hstep;
    const unsigned ldsw = (unsigned)wid * 1024u;
    const int aoff = lds_byte(wr * 64 + fr, fq * 8), boff = lds_byte(wc * 32 + fr, fq * 8);
#define PG8_SA(b, h) (((b) * 2 + (h)) * HTB)
#define PG8_SB(b, h) ((4 + (b) * 2 + (h)) * HTB)
#define PG8_STAGE(bufoff, gbase, voff) do { _Pragma("unroll") for (int _i = 0; _i < 2; ++_i) \
        __builtin_amdgcn_global_load_lds((const unsigned*)((const char*)(gbase) + (voff)[_i]), (PG8_LAS unsigned*)(lds + (bufoff) + ldsw + _i * 8192), 16, 0, 0); } while (0)
#define PG8_LDA(dst, b, h) do { _Pragma("unroll") for (int m = 0; m < 4; ++m) _Pragma("unroll") for (int k = 0; k < 2; ++k) dst[m][k] = *(const PG8_LAS bf16x8*)(lds + PG8_SA(b, h) + aoff + m * 2048 + k * 1024); } while (0)
#define PG8_LDB(dst, b, h) do { _Pragma("unroll") for (int n = 0; n < 2; ++n) _Pragma("unroll") for (int k = 0; k < 2; ++k) dst[n][k] = *(const PG8_LAS bf16x8*)(lds + PG8_SB(b, h) + boff + n * 2048 + k * 1024); } while (0)
#define PG8_MMA(ai, bj, At, Bt) do { __builtin_amdgcn_s_setprio(1); _Pragma("unroll") for (int m = 0; m < 4; ++m) _Pragma("unroll") for (int n = 0; n < 2; ++n) _Pragma("unroll") for (int k = 0; k < 2; ++k) \
        acc[ai][bj][m][n] = __builtin_amdgcn_mfma_f32_16x16x32_bf16(Bt[n][k], At[m][k], acc[ai][bj][m][n], 0, 0, 0); __builtin_amdgcn_s_setprio(0); } while (0)
#define PG8_WAIT_V(n) asm volatile("s_waitcnt vmcnt(" #n ")" ::: "memory")
#define PG8_WAIT_L(n) asm volatile("s_waitcnt lgkmcnt(" #n ")" ::: "memory")
#define PG8_BAR __builtin_amdgcn_s_barrier()
#define PG8_SCHED __builtin_amdgcn_sched_barrier(0)
    Unit cur, nxt; int ui = 0;
    if (!S.next(0, cur)) return;
    f32x4 acc[2][2][4][2];
#pragma unroll
    for (int a = 0; a < 2; ++a)
#pragma unroll
        for (int b = 0; b < 2; ++b)
#pragma unroll
            for (int m = 0; m < 4; ++m)
#pragma unroll
                for (int n = 0; n < 2; ++n) acc[a][b][m][n] = (f32x4){0.f, 0.f, 0.f, 0.f};
    bf16x8 At[4][2], B0[2][2], B1[2][2];
    const char* cA = (const char*)g.A + (size_t)cur.pm * tstep; const char* cB = (const char*)g.Bt + (size_t)cur.pn * tstep;
    S.a_ready(cur);
    PG8_STAGE(PG8_SB(0, 0), cB, voffB); PG8_STAGE(PG8_SA(0, 0), cA, voffA); PG8_STAGE(PG8_SB(0, 1), cB + hstep, voffB); PG8_STAGE(PG8_SA(0, 1), cA + hstep, voffA);
    if (wr == 1) PG8_BAR;
    PG8_WAIT_V(4); PG8_BAR;
    PG8_STAGE(PG8_SB(1, 0), cB + kstep, voffB); PG8_STAGE(PG8_SA(1, 0), cA + kstep, voffA); PG8_STAGE(PG8_SB(1, 1), cB + hstep + kstep, voffB);
    PG8_WAIT_V(6); PG8_BAR;
    PG8_STAMP();
    for (;;) {
        const bool has_next = S.next(ui + 1, nxt);
        const char* nA = has_next ? (const char*)g.A + (size_t)nxt.pm * tstep : cA; const char* nB = has_next ? (const char*)g.Bt + (size_t)nxt.pn * tstep : cB;
        for (int t = 0; t < nt; t += 2) {
            const bool last = (t == nt - 2);
            const char* a1 = cA + (size_t)(t + 1) * kstep;
            const char* a2 = last ? nA : cA + (size_t)(t + 2) * kstep; const char* b2 = last ? nB : cB + (size_t)(t + 2) * kstep;
            const char* a3 = a2 + kstep; const char* b3 = b2 + kstep;
            if (last && has_next) S.a_ready(nxt);
            PG8_LDB(B0, 0, 0); PG8_SCHED; PG8_LDA(At, 0, 0); PG8_STAGE(PG8_SA(1, 1), a1 + hstep, voffA);
            PG8_WAIT_L(8); PG8_BAR; PG8_WAIT_L(0); PG8_MMA(0, 0, At, B0); PG8_BAR; PG8_SCHED;
            PG8_LDB(B1, 0, 1); PG8_STAGE(PG8_SB(0, 0), b2, voffB);
            PG8_BAR; PG8_WAIT_L(0); PG8_MMA(0, 1, At, B1); PG8_BAR;
            PG8_LDA(At, 0, 1); PG8_STAGE(PG8_SA(0, 0), a2, voffA);
            PG8_BAR; PG8_WAIT_L(0); PG8_MMA(1, 0, At, B0); PG8_BAR; PG8_SCHED;
            PG8_STAGE(PG8_SB(0, 1), b2 + hstep, voffB);
            PG8_WAIT_V(6); PG8_BAR; PG8_MMA(1, 1, At, B1); PG8_BAR;
            PG8_LDB(B0, 1, 0); PG8_SCHED; PG8_LDA(At, 1, 0); PG8_STAGE(PG8_SA(0, 1), a2 + hstep, voffA);
            PG8_WAIT_L(8); PG8_BAR; PG8_WAIT_L(0); PG8_MMA(0, 0, At, B0); PG8_BAR; PG8_SCHED;
            PG8_LDB(B1, 1, 1); PG8_STAGE(PG8_SB(1, 0), b3, voffB);
            PG8_BAR; PG8_WAIT_L(0); PG8_MMA(0, 1, At, B1); PG8_BAR;
            PG8_LDA(At, 1, 1); PG8_STAGE(PG8_SA(1, 0), a3, voffA);
            PG8_BAR; PG8_WAIT_L(0); PG8_MMA(1, 0, At, B0); PG8_BAR; PG8_SCHED;
            PG8_STAGE(PG8_SB(1, 1), b3 + hstep, voffB);
            PG8_WAIT_V(6); PG8_BAR; PG8_MMA(1, 1, At, B1); PG8_BAR;
        }
        PG8_STAMP();
        if constexpr (!Epi::AFTER_DRAIN) { E(acc, cur, wr, wc, fr, fq); S.done(cur); }
        PG8_STAMP();
        if (!has_next) break;
#pragma unroll
        for (int a = 0; a < 2; ++a)
#pragma unroll
            for (int b = 0; b < 2; ++b)
#pragma unroll
                for (int m = 0; m < 4; ++m)
#pragma unroll
                    for (int n = 0; n < 2; ++n) acc[a][b][m][n] = (f32x4){0.f, 0.f, 0.f, 0.f};
        cur = nxt; cA = nA; cB = nB; ++ui;
    }
    PG8_WAIT_V(0);
    if (wr == 0) PG8_BAR;
    PG8_BAR;
    if constexpr (Epi::AFTER_DRAIN) { E.fused(acc, cur, wr, wc, fr, fq, lds, wid, lane); S.done(cur); }
    PG8_STAMP();
    if (STAMP && wid == 0) { stamps[lane] = lane < nts ? (((unsigned long long)(unsigned)ts_hi << 32) | (unsigned)ts_lo) : 0ull;
        if (lane == 62) stamps[62] = rt_entry; if (lane == 63) stamps[63] = (unsigned long long)wall_clock64(); }
#undef PG8_STAMP
#undef PG8_SA
#undef PG8_SB
#undef PG8_STAGE
#undef PG8_LDA
#undef PG8_LDB
#undef PG8_MMA
#undef PG8_WAIT_V
#undef PG8_WAIT_L
#undef PG8_BAR
#undef PG8_SCHED
}
}

using pg8::bf16_t; using pg8::bf16x8; using pg8::f32x4; using pg8::u32x4;
typedef unsigned u32x2 __attribute__((ext_vector_type(2)));

#ifndef MK_SINGLE
#define MK_SINGLE 1
#endif

constexpr int DM = 1024, NLAT = 32768, NROWS = 33280, INC = 3584, DFF = 2816, NGU = 5632;
constexpr float EPSV = 1e-6f;
constexpr int LDS_BYTES = 131072;

constexpr size_t SZ_WIN = (size_t)INC * DM * 2, SZ_WOUT = (size_t)DM * DM * 2, SZ_WGU = (size_t)NGU * DM * 2, SZ_WDN = (size_t)DM * DFF * 2;
constexpr size_t OFF_WIN = 0;
constexpr size_t OFF_WOUT = OFF_WIN + 2 * SZ_WIN;
constexpr size_t OFF_WGU = OFF_WOUT + 2 * SZ_WOUT;
constexpr size_t OFF_WDN = OFF_WGU + 2 * SZ_WGU;
constexpr size_t OFF_MODS = OFF_WDN + 2 * SZ_WDN;
constexpr size_t OFF_LB = OFF_MODS + 2 * 3 * 6144 * 4;
constexpr size_t OFF_HGD = OFF_LB + 2 * 2 * 512 * 4;
constexpr size_t OFF_RGAGG = OFF_HGD + 16 * 64 * 128 * 4;
constexpr size_t OFF_XCTX = OFF_RGAGG + (size_t)2 * 2 * 260 * 2 * 512 * 4;
constexpr size_t OFF_R1 = OFF_XCTX + (size_t)512 * 1024 * 4;
constexpr size_t OFF_R2 = OFF_R1 + (size_t)NROWS * INC * 2;
constexpr size_t OFF_R3 = OFF_R2 + (size_t)NROWS * DM * 2;
constexpr size_t OFF_R4 = OFF_R3 + (size_t)NROWS * DM * 2;
constexpr size_t WS_END = OFF_R4 + (size_t)NROWS * DM * 2;

struct Params { const float* in[21]; float* out; unsigned char* ws; };

__device__ __forceinline__ float bf2f(bf16_t b) { return __uint_as_float(((unsigned)b) << 16); }
__device__ __forceinline__ bf16_t f2bf(float f) { unsigned u = __float_as_uint(f); u += 0x7FFFu + ((u >> 16) & 1u); return (bf16_t)(u >> 16); }
__device__ __forceinline__ float sigmoidf_(float x) { return 1.0f / (1.0f + __expf(-x)); }
__device__ __forceinline__ float wave_sum(float v) {
#pragma unroll
    for (int o = 32; o >= 1; o >>= 1) v += __shfl_xor(v, o);
    return v;
}

struct EpiSwiglu {
    static constexpr bool PERM = false, AFTER_DRAIN = false;
    bf16_t* O; int ldc;
    __device__ __forceinline__ void operator()(const f32x4 (&acc)[2][2][4][2], const pg8::Unit& u, int wr, int wc, int fr, int fq) const {
        const int row0 = u.pm * 256 + wr * 64 + fr, col0 = u.pn * 128 + wc * 16 + 4 * fq;
#pragma unroll
        for (int ai = 0; ai < 2; ++ai)
#pragma unroll
            for (int m = 0; m < 4; ++m) { bf16_t* rowp = O + (size_t)(row0 + ai * 128 + m * 16) * ldc + col0;
#pragma unroll
                for (int bj = 0; bj < 2; ++bj) { const f32x4 g = acc[ai][bj][m][0], uu = acc[ai][bj][m][1]; float hv[4];
#pragma unroll
                    for (int j = 0; j < 4; ++j) hv[j] = g[j] * sigmoidf_(g[j]) * uu[j];
                    u32x2 w; w.x = pg8::cvt_pk_bf16(hv[0], hv[1]); w.y = pg8::cvt_pk_bf16(hv[2], hv[3]);
                    *(u32x2*)(rowp + bj * 64) = w; } }
    }
};

__device__ __forceinline__ void conv_tile(const float* __restrict__ src, int ldS, bf16_t* __restrict__ dst, int ldD, int kt, int nt, int mode, float* tile) {
    const int tid = threadIdx.x;
    { const int r = tid >> 4, c4 = (tid & 15) * 4;
#pragma unroll
      for (int it = 0; it < 2; ++it) { const int row = it * 32 + r; const float4 v = *(const float4*)(src + (size_t)(64 * kt + row) * ldS + 64 * nt + c4);
          float* tp = tile + row * 65 + c4; tp[0] = v.x; tp[1] = v.y; tp[2] = v.z; tp[3] = v.w; } }
    __syncthreads();
    { const int n = tid >> 3, k8 = (tid & 7) * 8; const int N = 64 * nt + n;
      const int drow = mode == 0 ? N : (32 * (N >> 4) + (N & 15) + (mode == 2 ? 16 : 0));
      float v[8];
#pragma unroll
      for (int j = 0; j < 8; ++j) v[j] = tile[(k8 + j) * 65 + n];
      u32x4 w; w.x = pg8::cvt_pk_bf16(v[0], v[1]); w.y = pg8::cvt_pk_bf16(v[2], v[3]); w.z = pg8::cvt_pk_bf16(v[4], v[5]); w.w = pg8::cvt_pk_bf16(v[6], v[7]);
      *(u32x4*)(dst + (size_t)drow * ldD + 64 * kt + k8) = w; }
    __syncthreads();
}

__device__ __forceinline__ void phase_prep(const Params& P, unsigned char* shm) {
    const int tid = threadIdx.x, G = gridDim.x, bid = blockIdx.x;
    float* tile = (float*)shm;
    float* sv = (float*)(shm + 16640);
    float* red = (float*)(shm + 16640 + 12288);
    for (int e = tid; e < 3072; e += 512) { const int v = e >> 10, d = e & 1023; const float x = v < 2 ? P.in[1][v * 1024 + d] : P.in[3][d]; sv[e] = x * sigmoidf_(x); }
    { const int gi = bid * 512 + tid; if (gi < 2048) { float* lb = (float*)(P.ws + OFF_LB); const int l = gi >> 10, r = gi & 1023;
        float val = 0.f; if (l == 1) { const float l0 = P.in[8][r], l1 = P.in[8][1024 + r]; val = 1.0f / (1.0f + expf(l0 - l1)); } lb[gi] = val; } }
    __syncthreads();
    for (int it = bid; it < 192; it += G) {
        const int l = it / 96, n0 = (it % 96) * 64, w = tid >> 6, lane = tid & 63;
        const float* wm = P.in[4] + (size_t)l * 1024 * 6144 + n0 + lane;
        float a0 = 0.f, a1 = 0.f, a2 = 0.f;
#pragma unroll 8
        for (int dd = 0; dd < 128; ++dd) { const int d = w * 128 + dd; const float wv = wm[(size_t)d * 6144]; a0 += sv[d] * wv; a1 += sv[1024 + d] * wv; a2 += sv[2048 + d] * wv; }
        red[(w * 3 + 0) * 64 + lane] = a0; red[(w * 3 + 1) * 64 + lane] = a1; red[(w * 3 + 2) * 64 + lane] = a2;
        __syncthreads();
        if (tid < 192) { const int v = tid >> 6, ln = tid & 63; float s = P.in[5][l * 6144 + n0 + ln];
#pragma unroll
            for (int ww = 0; ww < 8; ++ww) s += red[(ww * 3 + v) * 64 + ln];
            ((float*)(P.ws + OFF_MODS))[(size_t)(l * 3 + v) * 6144 + n0 + ln] = s; }
        __syncthreads();
    }
    for (int ti = bid; ti < 6528; ti += G) {
        const int l = ti / 3264; int r = ti % 3264;
        const float* src; bf16_t* dst; int ldS, ldD, ntn, mode;
        if (r < 896) { src = P.in[7] + (size_t)l * DM * INC; ldS = INC; dst = (bf16_t*)(P.ws + OFF_WIN + l * SZ_WIN); ldD = DM; ntn = 56; mode = 0; }
        else if (r < 1152) { r -= 896; src = P.in[17] + (size_t)l * DM * DM; ldS = DM; dst = (bf16_t*)(P.ws + OFF_WOUT + l * SZ_WOUT); ldD = DM; ntn = 16; mode = 0; }
        else if (r < 1856) { r -= 1152; src = P.in[18] + (size_t)l * DM * DFF; ldS = DFF; dst = (bf16_t*)(P.ws + OFF_WGU + l * SZ_WGU); ldD = DM; ntn = 44; mode = 1; }
        else if (r < 2560) { r -= 1856; src = P.in[19] + (size_t)l * DM * DFF; ldS = DFF; dst = (bf16_t*)(P.ws + OFF_WGU + l * SZ_WGU); ldD = DM; ntn = 44; mode = 2; }
        else { r -= 2560; src = P.in[20] + (size_t)l * DFF * DM; ldS = DM; dst = (bf16_t*)(P.ws + OFF_WDN + l * SZ_WDN); ldD = DFF; ntn = 16; mode = 0; }
        conv_tile(src, ldS, dst, ldD, r / ntn, r % ntn, mode, tile);
    }
}

struct RowOp {
    const float* xs_lat; const float* xs_ctx; float* xd_lat; float* xd_ctx;
    const bf16_t* y; const float* yw; const float* mods_y; int gate_idx;
    bf16_t* hdst; const float* hw; const float* mods_h; int shift_idx, scale_idx;
    int nrows;
};
__device__ __forceinline__ void phase_rowop(const RowOp& R) {
    const int w = threadIdx.x >> 6, lane = threadIdx.x & 63;
    for (int row = blockIdx.x * 8 + w; row < R.nrows; row += gridDim.x * 8) {
        const bool isctx = row >= NLAT; const int v = isctx ? 2 : (row >> 14);
        const float* xs = isctx ? R.xs_ctx + (size_t)(row - NLAT) * DM : R.xs_lat + (size_t)row * DM;
        float xv[16];
#pragma unroll
        for (int j = 0; j < 4; ++j) { const float4 t = *(const float4*)(xs + j * 256 + lane * 4); xv[4 * j] = t.x; xv[4 * j + 1] = t.y; xv[4 * j + 2] = t.z; xv[4 * j + 3] = t.w; }
        if (R.y) {
            float yv[16]; float ss = 0.f;
#pragma unroll
            for (int j = 0; j < 4; ++j) { const u32x2 t = *(const u32x2*)(R.y + (size_t)row * DM + j * 256 + lane * 4);
                yv[4 * j] = __uint_as_float(t.x << 16); yv[4 * j + 1] = __uint_as_float(t.x & 0xffff0000u); yv[4 * j + 2] = __uint_as_float(t.y << 16); yv[4 * j + 3] = __uint_as_float(t.y & 0xffff0000u); }
#pragma unroll
            for (int e = 0; e < 16; ++e) ss += yv[e] * yv[e];
            ss = wave_sum(ss); const float rs = rsqrtf(ss * (1.0f / 1024.0f) + EPSV);
            const float* gp = R.mods_y + (size_t)(v * 6 + R.gate_idx) * 1024;
            float* xd = isctx ? R.xd_ctx + (size_t)(row - NLAT) * DM : R.xd_lat + (size_t)row * DM;
#pragma unroll
            for (int j = 0; j < 4; ++j) { const int c0 = j * 256 + lane * 4; const float4 gt = *(const float4*)(gp + c0); const float4 wt = *(const float4*)(R.yw + c0);
                xv[4 * j] += gt.x * (yv[4 * j] * rs * wt.x); xv[4 * j + 1] += gt.y * (yv[4 * j + 1] * rs * wt.y); xv[4 * j + 2] += gt.z * (yv[4 * j + 2] * rs * wt.z); xv[4 * j + 3] += gt.w * (yv[4 * j + 3] * rs * wt.w);
                float4 o; o.x = xv[4 * j]; o.y = xv[4 * j + 1]; o.z = xv[4 * j + 2]; o.w = xv[4 * j + 3]; *(float4*)(xd + c0) = o; }
        }
        if (R.hdst) {
            float ss = 0.f;
#pragma unroll
            for (int e = 0; e < 16; ++e) ss += xv[e] * xv[e];
            ss = wave_sum(ss); const float rs = rsqrtf(ss * (1.0f / 1024.0f) + EPSV);
            const float* shp = R.mods_h + (size_t)(v * 6 + R.shift_idx) * 1024; const float* scp = R.mods_h + (size_t)(v * 6 + R.scale_idx) * 1024;
#pragma unroll
            for (int j = 0; j < 4; ++j) { const int c0 = j * 256 + lane * 4; const float4 sh = *(const float4*)(shp + c0); const float4 sc = *(const float4*)(scp + c0); const float4 wt = *(const float4*)(R.hw + c0);
                const float h0 = xv[4 * j] * rs * wt.x * (1.0f + sc.x) + sh.x, h1 = xv[4 * j + 1] * rs * wt.y * (1.0f + sc.y) + sh.y;
                const float h2 = xv[4 * j + 2] * rs * wt.z * (1.0f + sc.z) + sh.z, h3 = xv[4 * j + 3] * rs * wt.w * (1.0f + sc.w) + sh.w;
                u32x2 o; o.x = pg8::cvt_pk_bf16(h0, h1); o.y = pg8::cvt_pk_bf16(h2, h3); *(u32x2*)(R.hdst + (size_t)row * DM + c0) = o; }
        }
    }
}

constexpr int HG_AOP = 0, HG_QH = 10752, HG_KH = 19456, HG_KT = 28160, HG_BOP = 38400, HG_OBUF = 81408, HG_GRP = 98304, HG_ETOT = 100352;
constexpr int AOP_LD = 168, QH_LD = 136, KT_LD = 40, OB_LD = 132;

__device__ __forceinline__ int hg_row(int b, int d, int j, int s_in) {
    if (j == 0) { const int tc = d ? 255 - s_in : s_in; return NLAT + b * 256 + tc; }
    const int sl = (j - 1) * 256 + s_in; const int tl = d ? 16383 - sl : sl; return b * 16384 + tl;
}

template <int MODE>
__device__ __forceinline__ void hg_run(const Params& P, int layer, int b, int h, int d, int j, bool combine, unsigned char* shm) {
    const int tid = threadIdx.x, w = tid >> 6, lane = tid & 63, c = lane & 15, q = lane >> 4;
    bf16_t* Aop = (bf16_t*)(shm + HG_AOP); bf16_t* Qh = (bf16_t*)(shm + HG_QH); bf16_t* Kh = (bf16_t*)(shm + HG_KH); bf16_t* Kt = (bf16_t*)(shm + HG_KT);
    bf16_t* Bop = (bf16_t*)(shm + HG_BOP); float* Obuf = (float*)(shm + HG_OBUF); float* grp = (float*)(shm + HG_GRP); float* etot = (float*)(shm + HG_ETOT);
    const bf16_t* p = (const bf16_t*)(P.ws + OFF_R1);
    bf16_t* mix = (bf16_t*)(P.ws + OFF_R3);
    float* states = (float*)(P.ws + OFF_R4);
    const int seq = (b * 4 + h) * 2 + d;
    const int k1 = tid & 127, tg = tid >> 7;
    const float lbv = ((const float*)(P.ws + OFF_LB))[(layer * 2 + d) * 512 + h * 128 + k1];
    const float oml = 1.0f - lbv;
    f32x4 Sacc[8];
    if (MODE == 3 && j > 0) {
        const float* st = states + ((size_t)seq * 64 + (j - 1)) * 16384;
#pragma unroll
        for (int nv = 0; nv < 8; ++nv)
#pragma unroll
            for (int i = 0; i < 4; ++i) Sacc[nv][i] = st[(16 * w + 4 * q + i) * 128 + 16 * nv + c];
    } else {
#pragma unroll
        for (int nv = 0; nv < 8; ++nv) Sacc[nv] = (f32x4){0.f, 0.f, 0.f, 0.f};
    }
    if (MODE == 3) {
#pragma unroll
        for (int nv = 0; nv < 8; ++nv) { u32x2 wv; wv.x = pg8::cvt_pk_bf16(Sacc[nv][0], Sacc[nv][1]); wv.y = pg8::cvt_pk_bf16(Sacc[nv][2], Sacc[nv][3]);
            *(u32x2*)(Bop + (16 * nv + c) * AOP_LD + 32 + 16 * w + 4 * q) = wv; }
    }
    float suptot = 0.f;
    const size_t colq = (size_t)h * 128 + k1, colz = (size_t)512 * (1 + d) + h * 128 + k1, colv = (size_t)1536 + h * 128 + k1;
    for (int ch = 0; ch < 8; ++ch) {
        {
            float gl[8], kk[8], qs[8]; bf16_t vr[8];
#pragma unroll
            for (int i = 0; i < 8; ++i) {
                const int t = 8 * tg + i; const size_t rb = (size_t)hg_row(b, d, j, ch * 32 + t) * INC;
                const float qr = bf2f(p[rb + colq]); float z = bf2f(p[rb + colz]); vr[i] = p[rb + colv];
                z = fminf(fmaxf(z, -40.f), 40.f);
                const float ez = __expf(-z); const float sg = 1.0f / (1.0f + ez); const float f = lbv + oml * sg;
                gl[i] = __logf(f); kk[i] = oml * (ez / (1.0f + ez)); qs[i] = qr * sigmoidf_(qr);
            }
            float run = 0.f;
#pragma unroll
            for (int i = 0; i < 8; ++i) { run += gl[i]; gl[i] = run; }
            grp[tg * 128 + k1] = run;
            __syncthreads();
            const float g0 = grp[k1], g1 = grp[128 + k1], g2 = grp[256 + k1], g3 = grp[384 + k1];
            const float tot = (g0 + g1) + (g2 + g3);
            const float off = tg == 0 ? 0.f : (tg == 1 ? g0 : (tg == 2 ? g0 + g1 : g0 + g1 + g2));
#pragma unroll
            for (int i = 0; i < 8; ++i) {
                const int t = 8 * tg + i; const float cum = off + gl[i];
                const bf16_t kh = f2bf(kk[i] * __expf(tot - cum));
                if (MODE == 3) { Aop[t * AOP_LD + 32 + k1] = f2bf(qs[i] * __expf(cum)); Qh[t * QH_LD + k1] = f2bf(qs[i] * __expf(cum - tot)); Kh[t * QH_LD + k1] = kh; }
                Kt[k1 * KT_LD + t] = kh; Bop[k1 * AOP_LD + t] = vr[i];
            }
            if (tg == 0) { etot[k1] = __expf(tot); suptot += tot; }
        }
        __syncthreads();
        if (MODE == 3 && w < 4) {
            const int mt = w >> 1, ms = w & 1;
            f32x4 sc = (f32x4){0.f, 0.f, 0.f, 0.f};
            if (ms <= mt) {
#pragma unroll
                for (int k4 = 0; k4 < 4; ++k4) { const bf16x8 a = *(const bf16x8*)(Qh + (16 * mt + c) * QH_LD + 32 * k4 + 8 * q); const bf16x8 bb = *(const bf16x8*)(Kh + (16 * ms + c) * QH_LD + 32 * k4 + 8 * q);
                    sc = __builtin_amdgcn_mfma_f32_16x16x32_bf16(a, bb, sc, 0, 0, 0); }
            }
#pragma unroll
            for (int i = 0; i < 4; ++i) { const int t = 16 * mt + 4 * q + i, s = 16 * ms + c; Aop[t * AOP_LD + s] = f2bf(s <= t ? sc[i] : 0.f); }
        }
        __syncthreads();
        if (MODE == 3) {
            f32x4 Oacc[2];
#pragma unroll
            for (int mt = 0; mt < 2; ++mt) { Oacc[mt] = (f32x4){0.f, 0.f, 0.f, 0.f};
#pragma unroll
                for (int k5 = 0; k5 < 5; ++k5) { const bf16x8 a = *(const bf16x8*)(Aop + (16 * mt + c) * AOP_LD + 32 * k5 + 8 * q); const bf16x8 bb = *(const bf16x8*)(Bop + (16 * w + c) * AOP_LD + 32 * k5 + 8 * q);
                    Oacc[mt] = __builtin_amdgcn_mfma_f32_16x16x32_bf16(a, bb, Oacc[mt], 0, 0, 0); }
#pragma unroll
                for (int i = 0; i < 4; ++i) Obuf[(16 * mt + 4 * q + i) * OB_LD + 16 * w + c] = Oacc[mt][i]; }
        }
        {
            const float e0 = etot[16 * w + 4 * q], e1 = etot[16 * w + 4 * q + 1], e2 = etot[16 * w + 4 * q + 2], e3 = etot[16 * w + 4 * q + 3];
            const bf16x8 a = *(const bf16x8*)(Kt + (16 * w + c) * KT_LD + 8 * q);
#pragma unroll
            for (int nv = 0; nv < 8; ++nv) { Sacc[nv][0] *= e0; Sacc[nv][1] *= e1; Sacc[nv][2] *= e2; Sacc[nv][3] *= e3;
                const bf16x8 bb = *(const bf16x8*)(Bop + (16 * nv + c) * AOP_LD + 8 * q);
                Sacc[nv] = __builtin_amdgcn_mfma_f32_16x16x32_bf16(a, bb, Sacc[nv], 0, 0, 0); }
        }
        __syncthreads();
        if (MODE == 3) {
#pragma unroll
            for (int nv = 0; nv < 8; ++nv) { u32x2 wv; wv.x = pg8::cvt_pk_bf16(Sacc[nv][0], Sacc[nv][1]); wv.y = pg8::cvt_pk_bf16(Sacc[nv][2], Sacc[nv][3]);
                *(u32x2*)(Bop + (16 * nv + c) * AOP_LD + 32 + 16 * w + 4 * q) = wv; }
            const int t = tid >> 4, v0 = (tid & 15) * 8;
            const int row = hg_row(b, d, j, ch * 32 + t);
            float o[8];
            { const float4 a0 = *(const float4*)(Obuf + t * OB_LD + v0), a1 = *(const float4*)(Obuf + t * OB_LD + v0 + 4);
              o[0] = a0.x; o[1] = a0.y; o[2] = a0.z; o[3] = a0.w; o[4] = a1.x; o[5] = a1.y; o[6] = a1.z; o[7] = a1.w; }
            bf16_t* mp = mix + (size_t)row * DM + h * 128 + v0;
            if (!combine) {
                u32x4 wv; wv.x = pg8::cvt_pk_bf16(o[0], o[1]); wv.y = pg8::cvt_pk_bf16(o[2], o[3]); wv.z = pg8::cvt_pk_bf16(o[4], o[5]); wv.w = pg8::cvt_pk_bf16(o[6], o[7]);
                *(u32x4*)mp = wv;
            } else {
                const u32x4 pv = *(const u32x4*)mp;
                o[0] += __uint_as_float(pv.x << 16); o[1] += __uint_as_float(pv.x & 0xffff0000u); o[2] += __uint_as_float(pv.y << 16); o[3] += __uint_as_float(pv.y & 0xffff0000u);
                o[4] += __uint_as_float(pv.z << 16); o[5] += __uint_as_float(pv.z & 0xffff0000u); o[6] += __uint_as_float(pv.w << 16); o[7] += __uint_as_float(pv.w & 0xffff0000u);
                float ss = 0.f;
#pragma unroll
                for (int e = 0; e < 8; ++e) ss += o[e] * o[e];
                ss += __shfl_xor(ss, 1); ss += __shfl_xor(ss, 2); ss += __shfl_xor(ss, 4); ss += __shfl_xor(ss, 8);
                const float rs = rsqrtf(ss * (1.0f / 128.0f) + EPSV);
                const u32x4 gv = *(const u32x4*)(p + (size_t)row * INC + 2048 + h * 128 + v0);
                float g[8]; g[0] = __uint_as_float(gv.x << 16); g[1] = __uint_as_float(gv.x & 0xffff0000u); g[2] = __uint_as_float(gv.y << 16); g[3] = __uint_as_float(gv.y & 0xffff0000u);
                g[4] = __uint_as_float(gv.z << 16); g[5] = __uint_as_float(gv.z & 0xffff0000u); g[6] = __uint_as_float(gv.w << 16); g[7] = __uint_as_float(gv.w & 0xffff0000u);
                const float* gn = P.in[9] + layer * 128 + v0;
                float r[8];
#pragma unroll
                for (int e = 0; e < 8; ++e) r[e] = o[e] * rs * gn[e] * (g[e] * sigmoidf_(g[e]));
                u32x4 wv; wv.x = pg8::cvt_pk_bf16(r[0], r[1]); wv.y = pg8::cvt_pk_bf16(r[2], r[3]); wv.z = pg8::cvt_pk_bf16(r[4], r[5]); wv.w = pg8::cvt_pk_bf16(r[6], r[7]);
                *(u32x4*)mp = wv;
            }
        }
    }
    if (MODE == 1) {
        float* st = states + ((size_t)seq * 64 + j) * 16384;
#pragma unroll
        for (int nv = 0; nv < 8; ++nv)
#pragma unroll
            for (int i = 0; i < 4; ++i) st[(16 * w + 4 * q + i) * 128 + 16 * nv + c] = Sacc[nv][i];
        if (tg == 0) ((float*)(P.ws + OFF_HGD))[((size_t)seq * 64 + j) * 128 + k1] = __expf(suptot);
    }
    __syncthreads();
}

__device__ __forceinline__ float gelu_tanh(float x) { const float u = 0.7978845608028654f * (x + 0.044715f * x * x * x); const float e = __expf(2.0f * u); const float th = 1.0f - 2.0f / (e + 1.0f); return 0.5f * x * (1.0f + th); }

template <int MODE  >
__device__ __forceinline__ void rg_item(const Params& P, int layer, int b, int ci, unsigned char* shm) {
    const int tid = threadIdx.x, c = tid, w = tid >> 6, i = tid & 63;
    float* uL = (float*)shm;
    const bf16_t* p = (const bf16_t*)(P.ws + OFF_R1);
    bf16_t* mix = (bf16_t*)(P.ws + OFF_R3);
    float* hf = (float*)(P.ws + OFF_R2);
    float* agg = (float*)(P.ws + OFF_RGAGG);
    const bool isctx = ci < 4;
    const int T0 = isctx ? ci * 64 : (ci - 4) * 64;
    const int rowbase = isctx ? NLAT + b * 256 : b * 16384;
    const int seglo = isctx ? 0 : T0, seghi = isctx ? 256 : T0 + 64;
    {
        const float* cw = P.in[10] + (size_t)layer * 4 * 512 + c; const float cw0 = cw[0], cw1 = cw[512], cw2 = cw[1024], cw3 = cw[1536]; const float cb = P.in[11][layer * 512 + c];
        const bf16_t* pc = p + (size_t)rowbase * INC + 2560 + c;
        float xm2 = (T0 - 2 >= seglo) ? bf2f(pc[(size_t)(T0 - 2) * INC]) : 0.f;
        float xm1 = (T0 - 1 >= seglo) ? bf2f(pc[(size_t)(T0 - 1) * INC]) : 0.f;
        float x0 = bf2f(pc[(size_t)T0 * INC]);
#pragma unroll 4
        for (int t = 0; t < 64; ++t) {
            const float xp1 = (T0 + t + 1 < seghi) ? bf2f(pc[(size_t)(T0 + t + 1) * INC]) : 0.f;
            uL[(w * 64 + t) * 64 + i] = cw0 * xm2 + cw1 * xm1 + cw2 * x0 + cw3 * xp1 + cb;
            xm2 = xm1; xm1 = x0; x0 = xp1;
        }
    }
    __syncthreads();
#pragma unroll 1
    for (int d = 0; d < 2; ++d) {
        float Wa[64], Wx[64];
        { const float* wa = P.in[12] + ((size_t)((layer * 2 + d) * 8 + w) * 64) * 64 + i; const float* wx = P.in[14] + ((size_t)((layer * 2 + d) * 8 + w) * 64) * 64 + i;
#pragma unroll
          for (int k = 0; k < 64; ++k) { Wa[k] = wa[k * 64]; Wx[k] = wx[k * 64]; } }
        const float ba = P.in[13][(layer * 2 + d) * 512 + c], bx = P.in[15][(layer * 2 + d) * 512 + c], lam = P.in[16][(layer * 2 + d) * 512 + c];
        const float c8 = -8.0f * log1pf(expf(-lam));
        const int csd = d == 0 ? ci : (isctx ? 3 - ci : 4 + (259 - ci));
        float* ag = agg + ((size_t)((d * 2 + b) * 260 + csd) * 2) * 512 + c;
        float h = MODE == 1 ? ag[0] : 0.f; float Pp = 1.0f;
#pragma unroll 1
        for (int tt = 0; tt < 64; ++tt) {
            const int t = d ? 63 - tt : tt;
            const float4* up = (const float4*)(uL + (w * 64 + t) * 64);
            float r0 = ba, r1 = 0.f, x0_ = bx, x1_ = 0.f;
#pragma unroll
            for (int k4 = 0; k4 < 16; ++k4) { if ((k4 & 3) == 0) asm volatile("" ::: "memory"); const float4 u4 = up[k4];
                r0 += u4.x * Wa[4 * k4]; r1 += u4.y * Wa[4 * k4 + 1]; r0 += u4.z * Wa[4 * k4 + 2]; r1 += u4.w * Wa[4 * k4 + 3];
                x0_ += u4.x * Wx[4 * k4]; x1_ += u4.y * Wx[4 * k4 + 1]; x0_ += u4.z * Wx[4 * k4 + 2]; x1_ += u4.w * Wx[4 * k4 + 3]; }
            const float r = sigmoidf_(r0 + r1), ig = sigmoidf_(x0_ + x1_);
            const float la = c8 * r; const float a = __expf(la); const float mult = sqrtf(-expm1f(2.0f * la));
            const float ut = uL[(w * 64 + t) * 64 + i];
            h = a * h + mult * ig * ut; Pp *= a;
            if (MODE == 1) {
                const size_t row = (size_t)(rowbase + T0 + t);
                if (d == 0) hf[row * 512 + c] = h;
                else { const float gt = bf2f(p[row * INC + 3072 + c]); mix[row * DM + 512 + c] = f2bf((hf[row * 512 + c] + h) * gelu_tanh(gt)); }
            }
        }
        if (MODE == 0) { ag[0] = Pp; ag[512] = h; }
    }
    __syncthreads();
}

__device__ __forceinline__ void phase_mix1(const Params& P, int layer, unsigned char* shm) {
    for (int it = blockIdx.x; it < 520; it += gridDim.x) rg_item<0>(P, layer, it / 260, it % 260, shm);
    asm volatile("" ::: "memory");
    for (int x = (blockIdx.x + 248) % gridDim.x; x < 1024; x += gridDim.x) { const int seq = x >> 6, j = x & 63; hg_run<1>(P, layer, seq >> 3, (seq >> 1) & 3, seq & 1, j, false, shm); }
}
__device__ __forceinline__ void phase_mix2(const Params& P) {
    const int tid = threadIdx.x;
    for (int it = blockIdx.x; it < 516; it += gridDim.x) {
        if (it < 4) {
            float* ag = (float*)(P.ws + OFF_RGAGG) + (size_t)it * 260 * 1024 + tid;
            float h = 0.f;
            for (int cs = 0; cs < 260; cs += 4) {
                float Pv[4], Hv[4];
#pragma unroll
                for (int u = 0; u < 4; ++u) { Pv[u] = ag[(size_t)(cs + u) * 1024]; Hv[u] = ag[(size_t)(cs + u) * 1024 + 512]; }
#pragma unroll
                for (int u = 0; u < 4; ++u) { ag[(size_t)(cs + u) * 1024] = h; h = Pv[u] * h + Hv[u]; }
            }
        } else {
            const int x = it - 4; const int seq = x >> 5; const int e = (x & 31) * 512 + tid; const int k = e >> 7;
            float* st = (float*)(P.ws + OFF_R4) + (size_t)seq * 64 * 16384 + e; const float* dd = (const float*)(P.ws + OFF_HGD) + (size_t)seq * 64 * 128 + k;
            float S = 0.f;
            for (int s0 = 0; s0 < 64; s0 += 8) {
                float Lv[8], Dv[8];
#pragma unroll
                for (int u = 0; u < 8; ++u) { Lv[u] = st[(size_t)(s0 + u) * 16384]; Dv[u] = dd[(s0 + u) * 128]; }
#pragma unroll
                for (int u = 0; u < 8; ++u) { S = Dv[u] * S + Lv[u]; st[(size_t)(s0 + u) * 16384] = S; }
            }
        }
    }
}
__device__ __forceinline__ void phase_mix3(const Params& P, int layer, unsigned char* shm) {
    const bool wc = layer == 0;
    const int nrg = wc ? 520 : 512, nj = wc ? 65 : 64, nhg = 8 * nj;
    for (int it = blockIdx.x; it < nrg; it += gridDim.x) { const int per = wc ? 260 : 256; const int b = it / per, ci = (it % per) + (wc ? 0 : 4); rg_item<1>(P, layer, b, ci, shm); }
    asm volatile("" ::: "memory");
    for (int x = (blockIdx.x + 248) % gridDim.x; x < nhg; x += gridDim.x) { const int bh = x / nj, j = (x % nj) + (wc ? 0 : 1); const int b = bh >> 2, h = bh & 3;
        hg_run<3>(P, layer, b, h, 0, j, false, shm);
        hg_run<3>(P, layer, b, h, 1, j == 0 ? 0 : 65 - j, true, shm); }
}

template <class Epi>
__device__ __forceinline__ void phase_gemm(const bf16_t* A, const bf16_t* Bt, int M, int N, int K, const Epi& E, unsigned char* shm) {
    pg8::Gemm g; g.A = A; g.Bt = Bt; g.M = M; g.N = N; g.K = K;
    pg8::StaticOrder S; S.init(M, N, (int)gridDim.x, (int)blockIdx.x);
    pg8::gemm_phase<Epi, pg8::StaticOrder, false>((PG8_LAS unsigned char*)shm, g, S, E, nullptr);
}

constexpr int N_PHASES = 20;
template <int ph> __device__ __forceinline__ void run_phase(const Params& P, unsigned char* shm) {
    unsigned char* ws = P.ws;
    const float* mods = (const float*)(ws + OFF_MODS);
    bf16_t* hA = (bf16_t*)(ws + OFF_R2); bf16_t* pbuf = (bf16_t*)(ws + OFF_R1); bf16_t* mix = (bf16_t*)(ws + OFF_R3); bf16_t* ybuf = (bf16_t*)(ws + OFF_R4); bf16_t* hid = (bf16_t*)(ws + OFF_R1);
    float* xctx = (float*)(ws + OFF_XCTX);
    if constexpr (ph == 0) { phase_prep(P, shm); return; }
    else if constexpr (ph == 1) {
        RowOp R; R.xs_lat = P.in[0]; R.xs_ctx = P.in[2]; R.xd_lat = nullptr; R.xd_ctx = nullptr; R.y = nullptr; R.yw = nullptr; R.mods_y = nullptr; R.gate_idx = 0;
        R.hdst = hA; R.hw = P.in[6]; R.mods_h = mods; R.shift_idx = 0; R.scale_idx = 1; R.nrows = NROWS;
        phase_rowop(R); return;
    } else {
    constexpr int layer = (ph - 2) / 9, sub = (ph - 2) % 9;
    constexpr bool last = layer == 1;
    constexpr int Mrows = last ? NLAT : NROWS;
    const float* ng = P.in[6] + (size_t)layer * 4 * 1024;
    const float* lmods = mods + (size_t)layer * 3 * 6144;
    if constexpr (sub == 0) { pg8::EpiBf16<0> E; E.O = pbuf; E.ldc = INC; E.bias = nullptr; E.split_cols = 0; E.split_stride = 0;
              phase_gemm(hA, (const bf16_t*)(ws + OFF_WIN + layer * SZ_WIN), NROWS, INC, DM, E, shm); }
    else if constexpr (sub == 1) { phase_mix1(P, layer, shm); }
    else if constexpr (sub == 2) { phase_mix2(P); }
    else if constexpr (sub == 3) { phase_mix3(P, layer, shm); }
    else if constexpr (sub == 4) { { pg8::EpiBf16<0> E; E.O = ybuf; E.ldc = DM; E.bias = nullptr; E.split_cols = 0; E.split_stride = 0;
              phase_gemm(mix, (const bf16_t*)(ws + OFF_WOUT + layer * SZ_WOUT), Mrows, DM, DM, E, shm); } }
    else if constexpr (sub == 5) { { RowOp R; R.xs_lat = layer == 0 ? P.in[0] : P.out; R.xs_ctx = layer == 0 ? P.in[2] : xctx; R.xd_lat = P.out; R.xd_ctx = xctx;
              R.y = ybuf; R.yw = ng + 1024; R.mods_y = lmods; R.gate_idx = 2;
              R.hdst = hA; R.hw = ng + 2048; R.mods_h = lmods; R.shift_idx = 3; R.scale_idx = 4; R.nrows = Mrows;
              phase_rowop(R); } }
    else if constexpr (sub == 6) { { EpiSwiglu E; E.O = hid; E.ldc = DFF;
              phase_gemm(hA, (const bf16_t*)(ws + OFF_WGU + layer * SZ_WGU), Mrows, NGU, DM, E, shm); } }
    else if constexpr (sub == 7) { { pg8::EpiBf16<0> E; E.O = ybuf; E.ldc = DM; E.bias = nullptr; E.split_cols = 0; E.split_stride = 0;
              phase_gemm(hid, (const bf16_t*)(ws + OFF_WDN + layer * SZ_WDN), Mrows, DM, DFF, E, shm); } }
    else if constexpr (sub == 8) { { RowOp R; R.xs_lat = P.out; R.xs_ctx = xctx; R.xd_lat = P.out; R.xd_ctx = xctx;
              R.y = ybuf; R.yw = ng + 3072; R.mods_y = lmods; R.gate_idx = 5;
              if (!last) { R.hdst = hA; R.hw = P.in[6] + (size_t)(layer + 1) * 4 * 1024; R.mods_h = mods + (size_t)(layer + 1) * 3 * 6144; R.shift_idx = 0; R.scale_idx = 1; }
              else { R.hdst = nullptr; R.hw = nullptr; R.mods_h = nullptr; R.shift_idx = 0; R.scale_idx = 0; }
              R.nrows = Mrows;
              phase_rowop(R); } }
    }
}

__global__ __launch_bounds__(512, 2) void mk_fwd(Params P, int ph_lo, int ph_hi) {
    extern __shared__ __attribute__((aligned(16))) unsigned char shm[];
    cg::grid_group grid = cg::this_grid();
#define MK_PHASE(k) if (ph_lo <= (k) && (k) < ph_hi) { if ((k) > ph_lo) grid.sync(); run_phase<(k)>(P, shm); }
    MK_PHASE(0) MK_PHASE(1) MK_PHASE(2) MK_PHASE(3) MK_PHASE(4) MK_PHASE(5) MK_PHASE(6) MK_PHASE(7) MK_PHASE(8) MK_PHASE(9)
    MK_PHASE(10) MK_PHASE(11) MK_PHASE(12) MK_PHASE(13) MK_PHASE(14) MK_PHASE(15) MK_PHASE(16) MK_PHASE(17) MK_PHASE(18) MK_PHASE(19)
#undef MK_PHASE
}

extern "C" void kernel_launch(void* const* d_in, const int* in_sizes, int n_in, void* d_out, int out_size, void* d_ws, size_t ws_size, hipStream_t stream) {
    static int grid = 0;
    if (grid == 0) {
        int dev = 0, cus = 0, per_cu = 0;
        hipGetDevice(&dev);
        hipDeviceGetAttribute(&cus, hipDeviceAttributeMultiprocessorCount, dev);
        hipFuncSetAttribute((const void*)mk_fwd, hipFuncAttributeMaxDynamicSharedMemorySize, LDS_BYTES);
        hipOccupancyMaxActiveBlocksPerMultiprocessor(&per_cu, (const void*)mk_fwd, 512, LDS_BYTES);
        if (per_cu < 1) per_cu = 1;
        grid = cus * 1;
        if (n_in != 21 || ws_size < WS_END) fprintf(stderr, "kernel_launch: unexpected n_in %d or ws_size %zu (need %zu)\n", n_in, ws_size, (size_t)WS_END);
        (void)hipGetLastError();
    }
    Params P{};
    for (int i = 0; i < 21; ++i) P.in[i] = (const float*)d_in[i];
    P.out = (float*)d_out; P.ws = (unsigned char*)d_ws;
#if MK_SINGLE
    int lo = 0, hi = N_PHASES;
    void* args[] = {&P, &lo, &hi};
    hipError_t e = hipLaunchCooperativeKernel((const void*)mk_fwd, dim3(grid), dim3(512), args, LDS_BYTES, stream);
    if (e != hipSuccess) fprintf(stderr, "cooperative launch failed: %s (grid %d)\n", hipGetErrorString(e), grid);
#else
    for (int ph = 0; ph < N_PHASES; ++ph) hipLaunchKernelGGL(mk_fwd, dim3(grid), dim3(512), LDS_BYTES, stream, P, ph, ph + 1);
#endif
}
```

```cpp
#include <hip/hip_runtime.h>
#include <hip/hip_cooperative_groups.h>
#include <cstdio>
namespace cg = cooperative_groups;
namespace pg8 {
#define PG8_LAS __attribute__((address_space(3)))
typedef unsigned short bf16_t;
typedef short bf16x8 __attribute__((ext_vector_type(8)));
typedef float f32x4 __attribute__((ext_vector_type(4)));
typedef unsigned u32x4 __attribute__((ext_vector_type(4)));
constexpr int BM = 256, BK = 64, HALF = 128, HTB = HALF * BK * 2  , STAGE_BYTES = 8 * HTB, NXCD = 8, WGM = 8;

__host__ __device__ __forceinline__ int lds_byte(int r, int c) { const int st = (r >> 4) * 2 + (c >> 5), rr = r & 15, cc = c & 31, ob = rr * 64 + cc * 2; return st * 1024 + (ob ^ (((ob >> 9) & 1) << 5)); }
__host__ __device__ __forceinline__ void stage_rc(int b, int& R, int& C) { const int st = b / 1024, sb = b % 1024, swz = sb ^ (((sb >> 9) & 1) << 5); R = (st >> 1) * 16 + swz / 64; C = (st & 1) * 32 + (swz % 64) / 2; }
__host__ __device__ __forceinline__ int perm32(int rho) { const int n = rho >> 4, i = rho & 15; return 8 * (i >> 2) + 4 * n + (i & 3); }

struct Unit { int pm, pn; };
struct Gemm { const bf16_t* A; const bf16_t* Bt; int M, N, K; };

struct StaticOrder {
    int nM, nN, nwg, G, c;
    __host__ __device__ void init(int M, int N, int G_, int c_) { nM = M / BM; nN = N / BM; nwg = nM * nN; G = G_; c = c_; }
    __host__ __device__ bool next(int i, Unit& u) const {
        const long L = (long)i * G + c; if (L >= nwg) return false;
        int wgid = (int)L; { const int q = nwg / NXCD, r = nwg % NXCD, xcd = wgid % NXCD, off = wgid / NXCD; wgid = (xcd < r ? xcd * (q + 1) : r * (q + 1) + (xcd - r) * q) + off; }
        const int nig = WGM * nN, gid = wgid / nig, fm = gid * WGM, gsz = (nM - fm) < WGM ? (nM - fm) : WGM;
        u.pm = fm + ((wgid % nig) % gsz); u.pn = (wgid % nig) / gsz; return true;
    }
    __device__ __forceinline__ void a_ready(const Unit&) const {}
    __device__ __forceinline__ void done(const Unit&) const {}
};
__device__ __forceinline__ unsigned cvt_pk_bf16(float lo, float hi) { unsigned r; asm volatile("v_cvt_pk_bf16_f32 %0, %1, %2" : "=v"(r) : "v"(lo), "v"(hi)); return r; }
typedef float f32x2 __attribute__((ext_vector_type(2)));
__device__ __forceinline__ f32x2 gelu_pk(f32x2 v) {
    const f32x2 av = __builtin_elementwise_abs(v), d = av * 0.2316418882f + 1.0f;
    f32x2 t; t.x = __builtin_amdgcn_rcpf(d.x); t.y = __builtin_amdgcn_rcpf(d.y);
    f32x2 q = t * 0.5307027145f + (-0.7265760135f); q = q * t + 0.7107068705f; q = q * t + (-0.142248368f); q = q * t + 0.127414796f; q = q * t;
    const f32x2 s = (v * v) * (-0.72134752044f);
    f32x2 e; e.x = __builtin_amdgcn_exp2f(s.x); e.y = __builtin_amdgcn_exp2f(s.y);
    const f32x2 m = v * (q * e), r = v - m;
    f32x2 o; o.x = v.x < 0.f ? m.x : r.x; o.y = v.y < 0.f ? m.y : r.y; return o;
}

struct EpiF32 {
    static constexpr bool PERM = false, AFTER_DRAIN = false;
    float* C; int ldc; const float* bias;
    __device__ __forceinline__ void operator()(const f32x4 (&acc)[2][2][4][2], const Unit& u, int wr, int wc, int fr, int fq) const {
        const int row0 = u.pm * BM + wr * 64 + fr, col0 = u.pn * BM + wc * 32 + 4 * fq;
        f32x4 bv[2][2];
#pragma unroll
        for (int bj = 0; bj < 2; ++bj)
#pragma unroll
            for (int n = 0; n < 2; ++n) bv[bj][n] = bias ? *(const f32x4*)(bias + col0 + bj * HALF + n * 16) : (f32x4){0.f, 0.f, 0.f, 0.f};
#pragma unroll
        for (int ai = 0; ai < 2; ++ai)
#pragma unroll
            for (int m = 0; m < 4; ++m) { float* rowp = C + (size_t)(row0 + ai * HALF + m * 16) * ldc + col0;
#pragma unroll
                for (int bj = 0; bj < 2; ++bj)
#pragma unroll
                    for (int n = 0; n < 2; ++n) *(f32x4*)(rowp + bj * HALF + n * 16) = acc[ai][bj][m][n] + bv[bj][n]; }
    }
};
template <int ACT  > struct EpiBf16 {
    static constexpr bool PERM = true, AFTER_DRAIN = false;
    bf16_t* O; int ldc; const float* bias; int split_cols; size_t split_stride;
    __device__ __forceinline__ void operator()(const f32x4 (&acc)[2][2][4][2], const Unit& u, int wr, int wc, int fr, int fq) const {
        const int row0 = u.pm * BM + wr * 64 + fr; int colt = u.pn * BM; bf16_t* base = O;
        if (split_cols) { const int t = colt / split_cols; base += (size_t)t * split_stride; colt -= t * split_cols; }
        const int col0 = colt + wc * 32 + 8 * fq, bcol0 = u.pn * BM + wc * 32 + 8 * fq;
        f32x4 bv[2][2];
#pragma unroll
        for (int bj = 0; bj < 2; ++bj)
#pragma unroll
            for (int n = 0; n < 2; ++n) bv[bj][n] = bias ? *(const f32x4*)(bias + bcol0 + bj * HALF + 4 * n) : (f32x4){0.f, 0.f, 0.f, 0.f};
#pragma unroll
        for (int ai = 0; ai < 2; ++ai)
#pragma unroll
            for (int m = 0; m < 4; ++m) { bf16_t* rowp = base + (size_t)(row0 + ai * HALF + m * 16) * ldc + col0;
#pragma unroll
                for (int bj = 0; bj < 2; ++bj) { f32x4 v0 = acc[ai][bj][m][0] + bv[bj][0], v1 = acc[ai][bj][m][1] + bv[bj][1];
                    if (ACT == 1) { f32x2 a = gelu_pk((f32x2){v0[0], v0[1]}), b = gelu_pk((f32x2){v0[2], v0[3]}), c = gelu_pk((f32x2){v1[0], v1[1]}), d = gelu_pk((f32x2){v1[2], v1[3]});
                        v0 = (f32x4){a.x, a.y, b.x, b.y}; v1 = (f32x4){c.x, c.y, d.x, d.y}; }
                    if (ACT == 2) {
#pragma unroll
                        for (int j = 0; j < 4; ++j) { v0[j] = 0.5f * v0[j] * (1.0f + erff(v0[j] * 0.70710678f)); v1[j] = 0.5f * v1[j] * (1.0f + erff(v1[j] * 0.70710678f)); } }
                    u32x4 w; w.x = cvt_pk_bf16(v0[0], v0[1]); w.y = cvt_pk_bf16(v0[2], v0[3]); w.z = cvt_pk_bf16(v1[0], v1[1]); w.w = cvt_pk_bf16(v1[2], v1[3]);
                    *(u32x4*)(rowp + bj * HALF) = w; } }
    }
};

template <class Epi, class Sched, bool ALIGN_EPI = false, bool SP2 = false>
__device__ __forceinline__ void gemm_phase(PG8_LAS unsigned char* lds, const Gemm g, const Sched& S, const Epi& E) {
    const int tid = threadIdx.x, wid = __builtin_amdgcn_readfirstlane(tid >> 6), lane = tid & 63, wr = wid >> 2, wc = wid & 3, fr = lane & 15, fq = lane >> 4;
    const int K = g.K, nt = K / BK;
    unsigned voffA[2], voffB[2];
#pragma unroll
    for (int i = 0; i < 2; ++i) { int R, C; stage_rc(tid * 16 + i * 8192, R, C); const int Rb = Epi::PERM ? ((R & ~31) + perm32(R & 31)) : R;
        voffA[i] = (unsigned)(R * K + C) * 2u; voffB[i] = (unsigned)(Rb * K + C) * 2u; }
    const size_t kstep = (size_t)(BK * 2);
    const size_t hstep = (size_t)HALF * K * 2;
    const size_t tstep = 2 * hstep;
    const unsigned ldsw = (unsigned)wid * 1024u;
    const int aoff = lds_byte(wr * 64 + fr, fq * 8), boff = lds_byte(wc * 32 + fr, fq * 8);
#define PG8_SA(b, h) (((b) * 2 + (h)) * HTB)
#define PG8_SB(b, h) ((4 + (b) * 2 + (h)) * HTB)
#define PG8_STAGE(bufoff, gbase, voff) do { _Pragma("unroll") for (int _i = 0; _i < 2; ++_i) \
        __builtin_amdgcn_global_load_lds((const unsigned*)((const char*)(gbase) + (voff)[_i]), (PG8_LAS unsigned*)(lds + (bufoff) + ldsw + _i * 8192), 16, 0, 0); } while (0)
#define PG8_LDA(dst, b, h) do { _Pragma("unroll") for (int m = 0; m < 4; ++m) _Pragma("unroll") for (int k = 0; k < 2; ++k) dst[m][k] = *(const PG8_LAS bf16x8*)(lds + PG8_SA(b, h) + aoff + m * 2048 + k * 1024); } while (0)
#define PG8_LDB(dst, b, h) do { _Pragma("unroll") for (int n = 0; n < 2; ++n) _Pragma("unroll") for (int k = 0; k < 2; ++k) dst[n][k] = *(const PG8_LAS bf16x8*)(lds + PG8_SB(b, h) + boff + n * 2048 + k * 1024); } while (0)
#define PG8_MMA(ai, bj, At, Bt) do { __builtin_amdgcn_s_setprio(1); _Pragma("unroll") for (int m = 0; m < 4; ++m) _Pragma("unroll") for (int n = 0; n < 2; ++n) _Pragma("unroll") for (int k = 0; k < 2; ++k) \
        acc[ai][bj][m][n] = __builtin_amdgcn_mfma_f32_16x16x32_bf16(Bt[n][k], At[m][k], acc[ai][bj][m][n], 0, 0, 0); __builtin_amdgcn_s_setprio(0); } while (0)
#define PG8_WAIT_V(n) asm volatile("s_waitcnt vmcnt(" #n ")" ::: "memory")
#define PG8_WAIT_L(n) asm volatile("s_waitcnt lgkmcnt(" #n ")" ::: "memory")
#define PG8_BAR __builtin_amdgcn_s_barrier()
#define PG8_SCHED __builtin_amdgcn_sched_barrier(0)
    Unit cur, nxt; int ui = 0;
    if (!S.next(0, cur)) return;
    f32x4 acc[2][2][4][2];
#pragma unroll
    for (int a = 0; a < 2; ++a)
#pragma unroll
        for (int b = 0; b < 2; ++b)
#pragma unroll
            for (int m = 0; m < 4; ++m)
#pragma unroll
                for (int n = 0; n < 2; ++n) acc[a][b][m][n] = (f32x4){0.f, 0.f, 0.f, 0.f};
    bf16x8 At[4][2], B0[2][2], B1[2][2];
    const char* cA = (const char*)g.A + (size_t)cur.pm * tstep; const char* cB = (const char*)g.Bt + (size_t)cur.pn * tstep;
    S.a_ready(cur);
    if constexpr (SP2) {
        PG8_STAGE(PG8_SB(0, 0), cB, voffB); PG8_STAGE(PG8_SB(0, 1), cB + hstep, voffB); PG8_STAGE(PG8_SA(0, 0), cA, voffA); PG8_STAGE(PG8_SA(0, 1), cA + hstep, voffA);
        if (wr == 1) PG8_BAR;
        PG8_WAIT_V(2); PG8_BAR;
        PG8_STAGE(PG8_SB(1, 0), cB + kstep, voffB); PG8_STAGE(PG8_SA(1, 0), cA + kstep, voffA); PG8_STAGE(PG8_SB(1, 1), cB + hstep + kstep, voffB);
        PG8_WAIT_V(6); PG8_BAR;
    } else {
        PG8_STAGE(PG8_SB(0, 0), cB, voffB); PG8_STAGE(PG8_SA(0, 0), cA, voffA); PG8_STAGE(PG8_SB(0, 1), cB + hstep, voffB); PG8_STAGE(PG8_SA(0, 1), cA + hstep, voffA);
        if (wr == 1) PG8_BAR;
        PG8_WAIT_V(4); PG8_BAR;
        PG8_STAGE(PG8_SB(1, 0), cB + kstep, voffB); PG8_STAGE(PG8_SA(1, 0), cA + kstep, voffA); PG8_STAGE(PG8_SB(1, 1), cB + hstep + kstep, voffB);
        PG8_WAIT_V(6); PG8_BAR;
    }
    for (;;) {
        const bool has_next = S.next(ui + 1, nxt);
        const char* nA = has_next ? (const char*)g.A + (size_t)nxt.pm * tstep : cA; const char* nB = has_next ? (const char*)g.Bt + (size_t)nxt.pn * tstep : cB;
        for (int t = 0; t < nt; t += 2) {
            const bool last = (t == nt - 2);
            const char* a1 = cA + (size_t)(t + 1) * kstep;
            const char* a2 = last ? nA : cA + (size_t)(t + 2) * kstep; const char* b2 = last ? nB : cB + (size_t)(t + 2) * kstep;
            const char* a3 = a2 + kstep; const char* b3 = b2 + kstep;
            if (last && has_next) S.a_ready(nxt);
            if constexpr (SP2) {
            PG8_LDB(B0, 0, 0); PG8_LDB(B1, 0, 1); PG8_SCHED; PG8_LDA(At, 0, 0); PG8_STAGE(PG8_SA(1, 1), a1 + hstep, voffA);
            PG8_WAIT_V(8); PG8_WAIT_L(0); PG8_BAR; PG8_MMA(0, 0, At, B0); PG8_MMA(0, 1, At, B1); PG8_BAR; PG8_SCHED;
            PG8_LDA(At, 0, 1); PG8_STAGE(PG8_SB(0, 0), b2, voffB); PG8_STAGE(PG8_SB(0, 1), b2 + hstep, voffB); PG8_STAGE(PG8_SA(0, 0), a2, voffA);
            PG8_WAIT_V(8); PG8_WAIT_L(0); PG8_BAR; PG8_MMA(1, 0, At, B0); PG8_MMA(1, 1, At, B1); PG8_BAR; PG8_SCHED;
            PG8_LDB(B0, 1, 0); PG8_LDB(B1, 1, 1); PG8_SCHED; PG8_LDA(At, 1, 0); PG8_STAGE(PG8_SA(0, 1), a2 + hstep, voffA);
            PG8_WAIT_V(8); PG8_WAIT_L(0); PG8_BAR; PG8_MMA(0, 0, At, B0); PG8_MMA(0, 1, At, B1); PG8_BAR; PG8_SCHED;
            PG8_LDA(At, 1, 1); PG8_STAGE(PG8_SB(1, 0), b3, voffB); PG8_STAGE(PG8_SB(1, 1), b3 + hstep, voffB); PG8_STAGE(PG8_SA(1, 0), a3, voffA);
            PG8_WAIT_V(8); PG8_WAIT_L(0); PG8_BAR; PG8_MMA(1, 0, At, B0); PG8_MMA(1, 1, At, B1); PG8_BAR; PG8_SCHED;
            } else {
            PG8_LDB(B0, 0, 0); PG8_SCHED; PG8_LDA(At, 0, 0); PG8_STAGE(PG8_SA(1, 1), a1 + hstep, voffA);
            PG8_WAIT_L(8); PG8_BAR; PG8_WAIT_L(0); PG8_MMA(0, 0, At, B0); PG8_BAR; PG8_SCHED;
            PG8_LDB(B1, 0, 1); PG8_STAGE(PG8_SB(0, 0), b2, voffB);
            PG8_BAR; PG8_WAIT_L(0); PG8_MMA(0, 1, At, B1); PG8_BAR;
            PG8_LDA(At, 0, 1); PG8_STAGE(PG8_SA(0, 0), a2, voffA);
            PG8_BAR; PG8_WAIT_L(0); PG8_MMA(1, 0, At, B0); PG8_BAR; PG8_SCHED;
            PG8_STAGE(PG8_SB(0, 1), b2 + hstep, voffB);
            PG8_WAIT_V(6); PG8_BAR; PG8_MMA(1, 1, At, B1); PG8_BAR;
            PG8_LDB(B0, 1, 0); PG8_SCHED; PG8_LDA(At, 1, 0); PG8_STAGE(PG8_SA(0, 1), a2 + hstep, voffA);
            PG8_WAIT_L(8); PG8_BAR; PG8_WAIT_L(0); PG8_MMA(0, 0, At, B0); PG8_BAR; PG8_SCHED;
            PG8_LDB(B1, 1, 1); PG8_STAGE(PG8_SB(1, 0), b3, voffB);
            PG8_BAR; PG8_WAIT_L(0); PG8_MMA(0, 1, At, B1); PG8_BAR;
            PG8_LDA(At, 1, 1); PG8_STAGE(PG8_SA(1, 0), a3, voffA);
            PG8_BAR; PG8_WAIT_L(0); PG8_MMA(1, 0, At, B0); PG8_BAR; PG8_SCHED;
            PG8_STAGE(PG8_SB(1, 1), b3 + hstep, voffB);
            PG8_WAIT_V(6); PG8_BAR; PG8_MMA(1, 1, At, B1); PG8_BAR;
            }
        }
        if constexpr (ALIGN_EPI) { if (wr == 0) PG8_BAR; }
        if constexpr (!Epi::AFTER_DRAIN) { E(acc, cur, wr, wc, fr, fq); S.done(cur); }
        if (!has_next) break;
#pragma unroll
        for (int a = 0; a < 2; ++a)
#pragma unroll
            for (int b = 0; b < 2; ++b)
#pragma unroll
                for (int m = 0; m < 4; ++m)
#pragma unroll
                    for (int n = 0; n < 2; ++n) acc[a][b][m][n] = (f32x4){0.f, 0.f, 0.f, 0.f};
        cur = nxt; cA = nA; cB = nB; ++ui;
        if constexpr (ALIGN_EPI) { if (wr == 1) PG8_BAR; }
    }
    PG8_WAIT_V(0);
    if constexpr (!ALIGN_EPI) { if (wr == 0) PG8_BAR; }
    PG8_BAR;
    if constexpr (Epi::AFTER_DRAIN) { E.fused(acc, cur, wr, wc, fr, fq, lds, wid, lane); S.done(cur); }
#undef PG8_SA
#undef PG8_SB
#undef PG8_STAGE
#undef PG8_LDA
#undef PG8_LDB
#undef PG8_MMA
#undef PG8_WAIT_V
#undef PG8_WAIT_L
#undef PG8_BAR
#undef PG8_SCHED
}
}

using pg8::bf16_t; using pg8::bf16x8; using pg8::f32x4; using pg8::u32x4;
typedef unsigned u32x2 __attribute__((ext_vector_type(2)));

#ifndef MK_SINGLE
#define MK_SINGLE 1
#endif

constexpr int DM = 1024, NLAT = 32768, NROWS = 33280, INC = 3584, DFF = 2816, NGU = 5632;
constexpr float EPSV = 1e-6f;
constexpr int LDS_BYTES = 131072;

constexpr size_t SZ_WIN = (size_t)INC * DM * 2, SZ_WOUT = (size_t)DM * DM * 2, SZ_WGU = (size_t)NGU * DM * 2, SZ_WDN = (size_t)DM * DFF * 2;
constexpr size_t OFF_WIN = 0;
constexpr size_t OFF_WOUT = OFF_WIN + 2 * SZ_WIN;
constexpr size_t OFF_WGU = OFF_WOUT + 2 * SZ_WOUT;
constexpr size_t OFF_WDN = OFF_WGU + 2 * SZ_WGU;
constexpr size_t OFF_MODS = OFF_WDN + 2 * SZ_WDN;
constexpr size_t OFF_LB = OFF_MODS + 2 * 3 * 6144 * 4;
constexpr size_t OFF_HGD = OFF_LB + 2 * 2 * 512 * 4;
constexpr size_t OFF_RGAGG = OFF_HGD + 16 * 64 * 128 * 4;
constexpr size_t OFF_XCTX = OFF_RGAGG + (size_t)2 * 2 * 260 * 2 * 512 * 4;
constexpr size_t OFF_WF = OFF_XCTX + (size_t)512 * 1024 * 4;
constexpr size_t OFF_BAR = OFF_WF + (size_t)32768 * 16;
constexpr size_t OFF_R1 = OFF_BAR + 16384;
constexpr size_t OFF_R2 = OFF_R1 + (size_t)NROWS * INC * 2;
constexpr size_t OFF_R3 = OFF_R2 + (size_t)NROWS * DM * 2;
constexpr size_t OFF_R4 = OFF_R3 + (size_t)NROWS * DM * 2;
constexpr size_t WS_END = OFF_R4 + (size_t)NROWS * DM * 2;

struct Params { const float* in[21]; float* out; unsigned char* ws; };

__device__ __forceinline__ float bf2f(bf16_t b) { return __uint_as_float(((unsigned)b) << 16); }
__device__ __forceinline__ bf16_t f2bf(float f) { unsigned u = __float_as_uint(f); u += 0x7FFFu + ((u >> 16) & 1u); return (bf16_t)(u >> 16); }
__device__ __forceinline__ float sigmoidf_(float x) { return __builtin_amdgcn_rcpf(1.0f + __expf(-x)); }
__device__ __forceinline__ float wave_sum(float v) {
#pragma unroll
    for (int o = 32; o >= 1; o >>= 1) v += __shfl_xor(v, o);
    return v;
}

struct EpiSwiglu {
    static constexpr bool PERM = false, AFTER_DRAIN = false;
    bf16_t* O; int ldc;
    __device__ __forceinline__ void operator()(const f32x4 (&acc)[2][2][4][2], const pg8::Unit& u, int wr, int wc, int fr, int fq) const {
        const int row0 = u.pm * 256 + wr * 64 + fr, col0 = u.pn * 128 + wc * 16 + 4 * fq;
#pragma unroll
        for (int ai = 0; ai < 2; ++ai)
#pragma unroll
            for (int m = 0; m < 4; ++m) { bf16_t* rowp = O + (size_t)(row0 + ai * 128 + m * 16) * ldc + col0;
#pragma unroll
                for (int bj = 0; bj < 2; ++bj) { const f32x4 g = acc[ai][bj][m][0], uu = acc[ai][bj][m][1];
                    typedef float f32x2 __attribute__((ext_vector_type(2)));
                    const f32x2 one2 = (f32x2){1.0f, 1.0f}, nl2e = (f32x2){-1.4426950408889634f, -1.4426950408889634f};
                    const f32x2 g0 = (f32x2){g[0], g[1]}, g1 = (f32x2){g[2], g[3]}, u0 = (f32x2){uu[0], uu[1]}, u1 = (f32x2){uu[2], uu[3]};
                    const f32x2 n0 = g0 * nl2e, n1 = g1 * nl2e;
                    const f32x2 t0 = (f32x2){__builtin_amdgcn_exp2f(n0.x), __builtin_amdgcn_exp2f(n0.y)} + one2, t1 = (f32x2){__builtin_amdgcn_exp2f(n1.x), __builtin_amdgcn_exp2f(n1.y)} + one2;
                    const f32x2 h0 = g0 * u0 * (f32x2){__builtin_amdgcn_rcpf(t0.x), __builtin_amdgcn_rcpf(t0.y)}, h1 = g1 * u1 * (f32x2){__builtin_amdgcn_rcpf(t1.x), __builtin_amdgcn_rcpf(t1.y)};
                    u32x2 w; w.x = pg8::cvt_pk_bf16(h0.x, h0.y); w.y = pg8::cvt_pk_bf16(h1.x, h1.y);
                    *(u32x2*)(rowp + bj * 64) = w; } }
    }
};

__device__ __forceinline__ void conv_tile(const float* __restrict__ src, int ldS, bf16_t* __restrict__ dst, int ldD, int kt, int nt, int mode, float* tile) {
    const int tid = threadIdx.x;
    { const int r = tid >> 4, c4 = (tid & 15) * 4;
#pragma unroll
      for (int it = 0; it < 2; ++it) { const int row = it * 32 + r; const float4 v = *(const float4*)(src + (size_t)(64 * kt + row) * ldS + 64 * nt + c4);
          float* tp = tile + row * 65 + c4; tp[0] = v.x; tp[1] = v.y; tp[2] = v.z; tp[3] = v.w; } }
    __syncthreads();
    { const int n = tid >> 3, k8 = (tid & 7) * 8; const int N = 64 * nt + n;
      const int drow = mode == 0 ? N : (32 * (N >> 4) + (N & 15) + (mode == 2 ? 16 : 0));
      float v[8];
#pragma unroll
      for (int j = 0; j < 8; ++j) v[j] = tile[(k8 + j) * 65 + n];
      u32x4 w; w.x = pg8::cvt_pk_bf16(v[0], v[1]); w.y = pg8::cvt_pk_bf16(v[2], v[3]); w.z = pg8::cvt_pk_bf16(v[4], v[5]); w.w = pg8::cvt_pk_bf16(v[6], v[7]);
      *(u32x4*)(dst + (size_t)drow * ldD + 64 * kt + k8) = w; }
    __syncthreads();
}

__device__ __forceinline__ void convert_tiles(const Params& P, unsigned char* shm, int t_lo, int t_hi) {
    const int tid = threadIdx.x, G = gridDim.x, bid = blockIdx.x;
    float* tile = (float*)shm;
    {
        const float* src = nullptr; bf16_t* dst = nullptr; int ldS = 0, ldD = 0, kt = 0, nt = 0, mode = 0;
#define WC_DECODE(TI) do { const int l_ = (TI) / 3264; int r_ = (TI) % 3264; int ntn_; \
        if (r_ < 896) { src = P.in[7] + (size_t)l_ * DM * INC; ldS = INC; dst = (bf16_t*)(P.ws + OFF_WIN + l_ * SZ_WIN); ldD = DM; ntn_ = 56; mode = 0; } \
        else if (r_ < 1152) { r_ -= 896; src = P.in[17] + (size_t)l_ * DM * DM; ldS = DM; dst = (bf16_t*)(P.ws + OFF_WOUT + l_ * SZ_WOUT); ldD = DM; ntn_ = 16; mode = 0; } \
        else if (r_ < 1856) { r_ -= 1152; src = P.in[18] + (size_t)l_ * DM * DFF; ldS = DFF; dst = (bf16_t*)(P.ws + OFF_WGU + l_ * SZ_WGU); ldD = DM; ntn_ = 44; mode = 1; } \
        else if (r_ < 2560) { r_ -= 1856; src = P.in[19] + (size_t)l_ * DM * DFF; ldS = DFF; dst = (bf16_t*)(P.ws + OFF_WGU + l_ * SZ_WGU); ldD = DM; ntn_ = 44; mode = 2; } \
        else { r_ -= 2560; src = P.in[20] + (size_t)l_ * DFF * DM; ldS = DM; dst = (bf16_t*)(P.ws + OFF_WDN + l_ * SZ_WDN); ldD = DFF; ntn_ = 16; mode = 0; } \
        kt = r_ / ntn_; nt = r_ % ntn_; } while (0)
#define WC_BAR() asm volatile("s_waitcnt lgkmcnt(0)\n\ts_barrier" ::: "memory")
        const int lr = tid >> 4, lc4 = (tid & 15) * 4;
        float4 pv0 = make_float4(0.f, 0.f, 0.f, 0.f), pv1 = pv0;
        int ti = t_lo + bid;
        if (ti < t_hi) { WC_DECODE(ti); pv0 = *(const float4*)(src + (size_t)(64 * kt + lr) * ldS + 64 * nt + lc4); pv1 = *(const float4*)(src + (size_t)(64 * kt + 32 + lr) * ldS + 64 * nt + lc4); }
        for (; ti < t_hi; ti += G) {
            { float* tp = tile + lr * 65 + lc4; tp[0] = pv0.x; tp[1] = pv0.y; tp[2] = pv0.z; tp[3] = pv0.w; tp += 32 * 65; tp[0] = pv1.x; tp[1] = pv1.y; tp[2] = pv1.z; tp[3] = pv1.w; }
            bf16_t* cdst = dst; const int cldD = ldD, ckt = kt, cnt = nt, cmode = mode;
            if (ti + G < t_hi) { WC_DECODE(ti + G); pv0 = *(const float4*)(src + (size_t)(64 * kt + lr) * ldS + 64 * nt + lc4); pv1 = *(const float4*)(src + (size_t)(64 * kt + 32 + lr) * ldS + 64 * nt + lc4); }
            WC_BAR();
            { const int n = tid >> 3, k8 = (tid & 7) * 8; const int N = 64 * cnt + n;
              const int drow = cmode == 0 ? N : (32 * (N >> 4) + (N & 15) + (cmode == 2 ? 16 : 0));
              float v[8];
#pragma unroll
              for (int jx = 0; jx < 8; ++jx) v[jx] = tile[(k8 + jx) * 65 + n];
              u32x4 wv; wv.x = pg8::cvt_pk_bf16(v[0], v[1]); wv.y = pg8::cvt_pk_bf16(v[2], v[3]); wv.z = pg8::cvt_pk_bf16(v[4], v[5]); wv.w = pg8::cvt_pk_bf16(v[6], v[7]);
              *(u32x4*)(cdst + (size_t)drow * cldD + 64 * ckt + k8) = wv; }
            WC_BAR();
        }
#undef WC_DECODE
#undef WC_BAR
        __syncthreads();
    }
}

__device__ __forceinline__ void phase_prep(const Params& P, unsigned char* shm) {
    const int tid = threadIdx.x, G = gridDim.x, bid = blockIdx.x;
    float* tile = (float*)shm;
    float* sv = (float*)(shm + 16640);
    float* red = (float*)(shm + 16640 + 12288);
    for (int e = tid; e < 3072; e += 512) { const int v = e >> 10, d = e & 1023; const float x = v < 2 ? P.in[1][v * 1024 + d] : P.in[3][d]; sv[e] = x * sigmoidf_(x); }
    { const int gi = bid * 512 + tid; if (gi < 2048) { float* lb = (float*)(P.ws + OFF_LB); const int l = gi >> 10, r = gi & 1023;
        float val = 0.f; if (l == 1) { const float l0 = P.in[8][r], l1 = P.in[8][1024 + r]; val = 1.0f / (1.0f + expf(l0 - l1)); } lb[gi] = val; } }
    for (int gi = bid * 512 + tid; gi < 32768; gi += G * 512) {
        const int ln = gi & 63, kk = (gi >> 6) & 1, nt = (gi >> 7) & 3, mat = (gi >> 9) & 1, ldn = gi >> 10;
        const float* src = (mat ? P.in[14] : P.in[12]) + (size_t)ldn * 4096 + (32 * kk + 8 * (ln >> 4)) * 64 + 16 * nt + (ln & 15);
        float v[8];
#pragma unroll
        for (int jj = 0; jj < 8; ++jj) v[jj] = src[jj * 64] * -1.4426950408889634f;
        u32x4 wv; wv.x = pg8::cvt_pk_bf16(v[0], v[1]); wv.y = pg8::cvt_pk_bf16(v[2], v[3]); wv.z = pg8::cvt_pk_bf16(v[4], v[5]); wv.w = pg8::cvt_pk_bf16(v[6], v[7]);
        ((u32x4*)(P.ws + OFF_WF))[gi] = wv;
    }
    __syncthreads();
    for (int it = bid; it < 192; it += G) {
        const int l = it / 96, n0 = (it % 96) * 64, w = tid >> 6, lane = tid & 63;
        const float* wm = P.in[4] + (size_t)l * 1024 * 6144 + n0 + lane;
        float a0 = 0.f, a1 = 0.f, a2 = 0.f;
#pragma unroll 32
        for (int dd = 0; dd < 128; ++dd) { const int d = w * 128 + dd; const float wv = wm[(size_t)d * 6144]; a0 += sv[d] * wv; a1 += sv[1024 + d] * wv; a2 += sv[2048 + d] * wv; }
        red[(w * 3 + 0) * 64 + lane] = a0; red[(w * 3 + 1) * 64 + lane] = a1; red[(w * 3 + 2) * 64 + lane] = a2;
        __syncthreads();
        if (tid < 192) { const int v = tid >> 6, ln = tid & 63; float s = P.in[5][l * 6144 + n0 + ln];
#pragma unroll
            for (int ww = 0; ww < 8; ++ww) s += red[(ww * 3 + v) * 64 + ln];
            ((float*)(P.ws + OFF_MODS))[(size_t)(l * 3 + v) * 6144 + n0 + ln] = s; }
        __syncthreads();
    }
    convert_tiles(P, shm, 0, 896);
}

struct RowOp {
    const float* xs_lat; const float* xs_ctx; float* xd_lat; float* xd_ctx;
    const bf16_t* xs_lat_b; bf16_t* xd_lat_b;
    const bf16_t* y; const float* yw; const float* mods_y; int gate_idx;
    bf16_t* hdst; const float* hw; const float* mods_h; int shift_idx, scale_idx;
    int nrows;
};
template <bool SRC_B, bool DST_B>
__device__ __forceinline__ void phase_rowop(const RowOp& R, unsigned char* shm) {
    const int w = threadIdx.x >> 6, lane = threadIdx.x & 63;
    PG8_LAS float* md = (PG8_LAS float*)shm;
    for (int e = threadIdx.x; e < 3 * 3 * 1024; e += 512) { const int v = e / 3072, k = (e / 1024) % 3, cidx = e & 1023;
        float val = 0.f;
        if (k == 0) { if (R.y) val = R.mods_y[(size_t)(v * 6 + R.gate_idx) * 1024 + cidx]; }
        else if (R.hdst) val = R.mods_h[(size_t)(v * 6 + (k == 1 ? R.shift_idx : R.scale_idx)) * 1024 + cidx];
        md[e] = val; }
    float4 ywv[4], hwv[4];
#pragma unroll
    for (int j = 0; j < 4; ++j) { ywv[j] = R.y ? *(const float4*)(R.yw + j * 256 + lane * 4) : make_float4(0.f, 0.f, 0.f, 0.f); hwv[j] = R.hdst ? *(const float4*)(R.hw + j * 256 + lane * 4) : make_float4(0.f, 0.f, 0.f, 0.f); }
    __syncthreads();
    float4 nx[2][4]; u32x2 ny[2][4];
#define ROW_LOAD(SLOT, ROW) do { const int r_ = (ROW); \
        if (SRC_B && r_ < NLAT) { const bf16_t* xb_ = R.xs_lat_b + (size_t)r_ * DM; \
            _Pragma("unroll") for (int j = 0; j < 4; ++j) { const u32x2 t_ = *(const u32x2*)(xb_ + j * 256 + lane * 4); nx[SLOT][j].x = __uint_as_float(t_.x); nx[SLOT][j].y = __uint_as_float(t_.y); } } \
        else { const float* xs_ = r_ >= NLAT ? R.xs_ctx + (size_t)(r_ - NLAT) * DM : R.xs_lat + (size_t)r_ * DM; \
        _Pragma("unroll") for (int j = 0; j < 4; ++j) nx[SLOT][j] = *(const float4*)(xs_ + j * 256 + lane * 4); } \
        if (R.y) { _Pragma("unroll") for (int j = 0; j < 4; ++j) ny[SLOT][j] = *(const u32x2*)(R.y + (size_t)r_ * DM + j * 256 + lane * 4); } } while (0)
    const int row0 = blockIdx.x * 8 + w, rstride = gridDim.x * 8;
    if (row0 < R.nrows) ROW_LOAD(0, row0);
    if (row0 + rstride < R.nrows) ROW_LOAD(1, row0 + rstride);
#pragma unroll 1
    for (int rowb = row0; rowb < R.nrows; rowb += 2 * rstride) {
#pragma unroll
      for (int u = 0; u < 2; ++u) {
        const int row = rowb + u * rstride;
        if (row < R.nrows) {
        const bool isctx = row >= NLAT; const int v = isctx ? 2 : (row >> 14);
        float xv[16]; u32x2 cy[4];
        if (SRC_B && !isctx) {
#pragma unroll
            for (int j = 0; j < 4; ++j) { const unsigned a_ = __float_as_uint(nx[u][j].x), b_ = __float_as_uint(nx[u][j].y);
                xv[4 * j] = __uint_as_float(a_ << 16); xv[4 * j + 1] = __uint_as_float(a_ & 0xffff0000u); xv[4 * j + 2] = __uint_as_float(b_ << 16); xv[4 * j + 3] = __uint_as_float(b_ & 0xffff0000u); cy[j] = ny[u][j]; }
        } else {
#pragma unroll
            for (int j = 0; j < 4; ++j) { xv[4 * j] = nx[u][j].x; xv[4 * j + 1] = nx[u][j].y; xv[4 * j + 2] = nx[u][j].z; xv[4 * j + 3] = nx[u][j].w; cy[j] = ny[u][j]; }
        }
        if (row + 2 * rstride < R.nrows) ROW_LOAD(u, row + 2 * rstride);
        const PG8_LAS float* mdv = md + v * 3072;
        if (R.y) {
            float yv[16]; float ss = 0.f;
#pragma unroll
            for (int j = 0; j < 4; ++j) { const u32x2 t = cy[j];
                yv[4 * j] = __uint_as_float(t.x << 16); yv[4 * j + 1] = __uint_as_float(t.x & 0xffff0000u); yv[4 * j + 2] = __uint_as_float(t.y << 16); yv[4 * j + 3] = __uint_as_float(t.y & 0xffff0000u); }
#pragma unroll
            for (int e = 0; e < 16; ++e) ss += yv[e] * yv[e];
            ss = wave_sum(ss); const float rs = rsqrtf(ss * (1.0f / 1024.0f) + EPSV);
            float* xd = isctx ? R.xd_ctx + (size_t)(row - NLAT) * DM : R.xd_lat + (size_t)row * DM;
#pragma unroll
            for (int j = 0; j < 4; ++j) { const int c0 = j * 256 + lane * 4; const f32x4 gt = *(const PG8_LAS f32x4*)(mdv + c0); const float4 wt = ywv[j];
                xv[4 * j] += gt[0] * (yv[4 * j] * rs * wt.x); xv[4 * j + 1] += gt[1] * (yv[4 * j + 1] * rs * wt.y); xv[4 * j + 2] += gt[2] * (yv[4 * j + 2] * rs * wt.z); xv[4 * j + 3] += gt[3] * (yv[4 * j + 3] * rs * wt.w);
                if (DST_B && !isctx) { u32x2 ob; ob.x = pg8::cvt_pk_bf16(xv[4 * j], xv[4 * j + 1]); ob.y = pg8::cvt_pk_bf16(xv[4 * j + 2], xv[4 * j + 3]); *(u32x2*)(R.xd_lat_b + (size_t)row * DM + c0) = ob;
                    xv[4 * j] = __uint_as_float(ob.x << 16); xv[4 * j + 1] = __uint_as_float(ob.x & 0xffff0000u); xv[4 * j + 2] = __uint_as_float(ob.y << 16); xv[4 * j + 3] = __uint_as_float(ob.y & 0xffff0000u);
                }
                else { float4 o; o.x = xv[4 * j]; o.y = xv[4 * j + 1]; o.z = xv[4 * j + 2]; o.w = xv[4 * j + 3]; *(float4*)(xd + c0) = o; } }
        }
        if (R.hdst) {
            float ss = 0.f;
#pragma unroll
            for (int e = 0; e < 16; ++e) ss += xv[e] * xv[e];
            ss = wave_sum(ss); const float rs = rsqrtf(ss * (1.0f / 1024.0f) + EPSV);
#pragma unroll
            for (int j = 0; j < 4; ++j) { const int c0 = j * 256 + lane * 4; const f32x4 sh = *(const PG8_LAS f32x4*)(mdv + 1024 + c0); const f32x4 sc = *(const PG8_LAS f32x4*)(mdv + 2048 + c0); const float4 wt = hwv[j];
                const float h0 = xv[4 * j] * rs * wt.x * (1.0f + sc[0]) + sh[0], h1 = xv[4 * j + 1] * rs * wt.y * (1.0f + sc[1]) + sh[1];
                const float h2 = xv[4 * j + 2] * rs * wt.z * (1.0f + sc[2]) + sh[2], h3 = xv[4 * j + 3] * rs * wt.w * (1.0f + sc[3]) + sh[3];
                u32x2 o; o.x = pg8::cvt_pk_bf16(h0, h1); o.y = pg8::cvt_pk_bf16(h2, h3); *(u32x2*)(R.hdst + (size_t)row * DM + c0) = o; }
        }
        }
      }
    }
    __syncthreads();
#undef ROW_LOAD
}

constexpr int HG_QT = 0, HG_QH = 8192, HG_KH = 16384, HG_V = 24576, HG_SIMG = 32768, HG_AIMG = 65536, HG_OBUF = 68096, HG_WTOT = 84992, HG_ETOT = 89088;
constexpr int AI_LD = 40, OB_LD = 132;
typedef short s16x4 __attribute__((ext_vector_type(4)));
#define LBAR() asm volatile("s_waitcnt lgkmcnt(0)\n\ts_barrier" ::: "memory")

__device__ __forceinline__ unsigned off_b(unsigned row, unsigned ch) { return 256u * row + 16u * (ch ^ (((row & 3u) << 2) | ((row >> 2) & 3u))); }
__device__ __forceinline__ unsigned rr16(unsigned lane, unsigned rb, unsigned s) { return off_b((lane & 15u) + 16u * rb, 4u * s + (lane >> 4)); }
__device__ __forceinline__ unsigned tr16(unsigned lane, unsigned c, unsigned ks, unsigned t) { const unsigned g = lane >> 4, q = (lane & 15u) >> 2, p = lane & 3u; return off_b(32u * ks + 8u * g + 4u * t + q, 2u * c + (p >> 1)) + 8u * (p & 1u); }
__device__ __forceinline__ bf16x8 trfrag(PG8_LAS unsigned char* img, unsigned lane, unsigned c, unsigned ks) {
    const s16x4 a = __builtin_amdgcn_ds_read_tr16_b64_v4i16((PG8_LAS s16x4*)(img + tr16(lane, c, ks, 0)));
    const s16x4 b = __builtin_amdgcn_ds_read_tr16_b64_v4i16((PG8_LAS s16x4*)(img + tr16(lane, c, ks, 1)));
    bf16x8 r; r[0] = a[0]; r[1] = a[1]; r[2] = a[2]; r[3] = a[3]; r[4] = b[0]; r[5] = b[1]; r[6] = b[2]; r[7] = b[3]; return r;
}
__device__ __forceinline__ void unpack8(const u32x4 v, float* f) {
    f[0] = __uint_as_float(v.x << 16); f[1] = __uint_as_float(v.x & 0xffff0000u); f[2] = __uint_as_float(v.y << 16); f[3] = __uint_as_float(v.y & 0xffff0000u);
    f[4] = __uint_as_float(v.z << 16); f[5] = __uint_as_float(v.z & 0xffff0000u); f[6] = __uint_as_float(v.w << 16); f[7] = __uint_as_float(v.w & 0xffff0000u);
}
__device__ __forceinline__ u32x4 pack8(const float* f) { u32x4 w; w.x = pg8::cvt_pk_bf16(f[0], f[1]); w.y = pg8::cvt_pk_bf16(f[2], f[3]); w.z = pg8::cvt_pk_bf16(f[4], f[5]); w.w = pg8::cvt_pk_bf16(f[6], f[7]); return w; }

__device__ __forceinline__ int hg_row(int b, int d, int j, int s_in) {
    if (j == 0) { const int tc = d ? 255 - s_in : s_in; return NLAT + b * 256 + tc; }
    const int sl = (j - 1) * 256 + s_in; const int tl = d ? 16383 - sl : sl; return b * 16384 + tl;
}

#define HG_DPP8(CTRL) asm volatile( \
    "v_mul_f32_dpp %0, %0, %0 " CTRL "\n\tv_mul_f32_dpp %1, %1, %1 " CTRL "\n\tv_mul_f32_dpp %2, %2, %2 " CTRL "\n\tv_mul_f32_dpp %3, %3, %3 " CTRL "\n\t" \
    "v_mul_f32_dpp %4, %4, %4 " CTRL "\n\tv_mul_f32_dpp %5, %5, %5 " CTRL "\n\tv_mul_f32_dpp %6, %6, %6 " CTRL "\n\tv_mul_f32_dpp %7, %7, %7 " CTRL \
    : "+v"(x0), "+v"(x1), "+v"(x2), "+v"(x3), "+v"(x4), "+v"(x5), "+v"(x6), "+v"(x7))
__device__ __forceinline__ void scan32_prod8(float& x0, float& x1, float& x2, float& x3, float& x4, float& x5, float& x6, float& x7) {
    asm volatile("s_nop 1" ::: );
    HG_DPP8("row_shr:1 row_mask:0xf bank_mask:0xf"); HG_DPP8("row_shr:2 row_mask:0xf bank_mask:0xf"); HG_DPP8("row_shr:4 row_mask:0xf bank_mask:0xf"); HG_DPP8("row_shr:8 row_mask:0xf bank_mask:0xf");
    HG_DPP8("row_bcast:15 row_mask:0xa bank_mask:0xf");
}
template <int MODE>
__device__ __forceinline__ void hg_run(const Params& P, int layer, int b, int h, int d, int j, bool combine, unsigned char* shm) {
    typedef float f32x2 __attribute__((ext_vector_type(2)));
    const int tid = threadIdx.x, w = tid >> 6, lane = tid & 63, c = lane & 15, q = lane >> 4;
    const int t1 = tid >> 4, cg = tid & 15;
    const int ts = lane & 31, hb = lane >> 5, cgs = 2 * w + hb;
    PG8_LAS unsigned char* L = (PG8_LAS unsigned char*)shm;
    PG8_LAS bf16_t* Aimg = (PG8_LAS bf16_t*)(L + HG_AIMG); PG8_LAS float* Obuf = (PG8_LAS float*)(L + HG_OBUF); PG8_LAS float* etot = (PG8_LAS float*)(L + HG_ETOT);
    const bf16_t* p = (const bf16_t*)(P.ws + OFF_R1);
    bf16_t* mix = (bf16_t*)(P.ws + OFF_R3);
    float* states = (float*)(P.ws + OFF_R2);
    const int seq = (b * 4 + h) * 2 + d;
    f32x2 lb2[4];
    { const float* lbp = (const float*)(P.ws + OFF_LB) + (layer * 2 + d) * 512 + h * 128 + 8 * cgs;
      const float4 l0 = *(const float4*)lbp, l1 = *(const float4*)(lbp + 4);
      lb2[0] = (f32x2){l0.x, l0.y}; lb2[1] = (f32x2){l0.z, l0.w}; lb2[2] = (f32x2){l1.x, l1.y}; lb2[3] = (f32x2){l1.z, l1.w}; }
    f32x4 Sacc[8];
    if (MODE == 3 && j > 0) {
        const float* st = states + ((size_t)seq * 64 + (j - 1)) * 16384;
#pragma unroll
        for (int n = 0; n < 8; ++n) Sacc[n] = *(const f32x4*)(st + (16 * n + c) * 128 + 16 * w + 4 * q);
    } else {
#pragma unroll
        for (int n = 0; n < 8; ++n) Sacc[n] = (f32x4){0.f, 0.f, 0.f, 0.f};
    }
    if (MODE == 3) {
#pragma unroll
        for (int n = 0; n < 8; ++n) { u32x2 wv; wv.x = pg8::cvt_pk_bf16(Sacc[n][0], Sacc[n][1]); wv.y = pg8::cvt_pk_bf16(Sacc[n][2], Sacc[n][3]);
            *(PG8_LAS u32x2*)(L + HG_SIMG + off_b(16 * n + c, 2 * w + (q >> 1)) + 8 * (q & 1)) = wv; }
        if (tid < 256) Aimg[(tid >> 4) * AI_LD + 16 + (tid & 15)] = 0;
    }
    f32x2 sup2[4];
#pragma unroll
    for (int e2 = 0; e2 < 4; ++e2) sup2[e2] = (f32x2){1.0f, 1.0f};
    f32x4 gn0 = (f32x4){0.f, 0.f, 0.f, 0.f}, gn1 = gn0;
    if (MODE == 3 && combine) { const float* gnp = P.in[9] + layer * 128 + 8 * cg; gn0 = *(const f32x4*)gnp; gn1 = *(const f32x4*)(gnp + 4); }
    const f32x2 one2 = (f32x2){1.0f, 1.0f}, nl2e = (f32x2){-1.4426950408889634f, -1.4426950408889634f}, tiny2 = (f32x2){1e-30f, 1e-30f};
    const int colq = h * 128 + 8 * cgs, colz = 512 * (1 + d) + h * 128 + 8 * cgs, colv = 1536 + h * 128 + 8 * cgs;
    u32x4 nq = (u32x4){0u, 0u, 0u, 0u}, nz, nv, ng = (u32x4){0u, 0u, 0u, 0u}, nm = (u32x4){0u, 0u, 0u, 0u}; int nrow = 0;
#define HG_LOAD(CH) do { { const bf16_t* pr = p + (size_t)hg_row(b, d, j, (CH) * 32 + ts) * INC; if (MODE == 3) nq = *(const u32x4*)(pr + colq); nz = *(const u32x4*)(pr + colz); nv = *(const u32x4*)(pr + colv); } \
        if (MODE == 3) { nrow = hg_row(b, d, j, (CH) * 32 + t1); if (combine) { ng = *(const u32x4*)(p + (size_t)nrow * INC + 2048 + h * 128 + 8 * cg); nm = *(const u32x4*)(mix + (size_t)nrow * DM + h * 128 + 8 * cg); } } } while (0)
    HG_LOAD(0);
#pragma unroll 1
    for (int ch = 0; ch < 8; ++ch) {
        const u32x4 cq = nq, cz = nz, cv = nv, cgate = ng, cmix = nm; const int row = nrow;
        if (ch < 7) HG_LOAD(ch + 1);
        {
            f32x2 g2[4], kk2[4], qs2[4];
            { float zf[8]; unpack8(cz, zf);
#pragma unroll
              for (int e2 = 0; e2 < 4; ++e2) { const f32x2 nzz = (f32x2){zf[2 * e2], zf[2 * e2 + 1]} * nl2e;
                  const f32x2 t = (f32x2){__builtin_amdgcn_exp2f(nzz.x), __builtin_amdgcn_exp2f(nzz.y)} + one2;
                  const f32x2 inv = (f32x2){__builtin_amdgcn_rcpf(t.x), __builtin_amdgcn_rcpf(t.y)};
                  const f32x2 oml = one2 - lb2[e2];
                  g2[e2] = lb2[e2] + oml * inv;
                  kk2[e2] = oml - oml * inv; } }
            if (MODE == 3) { float qf[8]; unpack8(cq, qf);
#pragma unroll
                for (int e2 = 0; e2 < 4; ++e2) { const f32x2 qv = (f32x2){qf[2 * e2], qf[2 * e2 + 1]}; const f32x2 nqq = qv * nl2e;
                    const f32x2 t = (f32x2){__builtin_amdgcn_exp2f(nqq.x), __builtin_amdgcn_exp2f(nqq.y)} + one2;
                    qs2[e2] = qv * (f32x2){__builtin_amdgcn_rcpf(t.x), __builtin_amdgcn_rcpf(t.y)}; } }
            { float s0 = g2[0].x, s1 = g2[0].y, s2 = g2[1].x, s3 = g2[1].y, s4 = g2[2].x, s5 = g2[2].y, s6 = g2[3].x, s7 = g2[3].y;
              scan32_prod8(s0, s1, s2, s3, s4, s5, s6, s7);
              g2[0] = (f32x2){s0, s1}; g2[1] = (f32x2){s2, s3}; g2[2] = (f32x2){s4, s5}; g2[3] = (f32x2){s6, s7}; }
            float qt[8], qh[8];
#pragma unroll
            for (int e2 = 0; e2 < 4; ++e2) {
                const f32x2 cm = __builtin_elementwise_max(g2[e2], tiny2);
                const f32x2 kt2 = kk2[e2] * (f32x2){__builtin_amdgcn_rcpf(cm.x), __builtin_amdgcn_rcpf(cm.y)};
                qh[2 * e2] = kt2.x; qh[2 * e2 + 1] = kt2.y;
                if (MODE == 3) { const f32x2 qt2 = qs2[e2] * g2[e2]; qt[2 * e2] = qt2.x; qt[2 * e2 + 1] = qt2.y; }
                if (MODE == 1) sup2[e2] *= g2[e2]; }
            if (MODE == 1) LBAR();
            const unsigned ob = off_b(ts, cgs);
            *(PG8_LAS u32x4*)(L + HG_QH + ob) = pack8(qh);
            *(PG8_LAS u32x4*)(L + HG_V + ob) = cv;
            if (MODE == 3) *(PG8_LAS u32x4*)(L + HG_QT + ob) = pack8(qt);
            if (ts == 31) { *(PG8_LAS f32x4*)(etot + 8 * cgs) = (f32x4){g2[0].x, g2[0].y, g2[1].x, g2[1].y}; *(PG8_LAS f32x4*)(etot + 8 * cgs + 4) = (f32x4){g2[2].x, g2[2].y, g2[3].x, g2[3].y}; }
        }
        LBAR();
        if (MODE == 3) {
            if (w < 3) {
                const int mt = w ? 1 : 0, ms = w == 2 ? 1 : 0;
                f32x4 sc = (f32x4){0.f, 0.f, 0.f, 0.f};
#pragma unroll
                for (int k4 = 0; k4 < 4; ++k4) { const bf16x8 a = *(const PG8_LAS bf16x8*)(L + HG_QT + rr16(lane, mt, k4)); const bf16x8 bb = *(const PG8_LAS bf16x8*)(L + HG_QH + rr16(lane, ms, k4));
                    sc = __builtin_amdgcn_mfma_f32_16x16x32_bf16(a, bb, sc, 0, 0, 0); }
#pragma unroll
                for (int i = 0; i < 4; ++i) { const int t = 16 * mt + 4 * q + i, s_ = 16 * ms + c; Aimg[t * AI_LD + s_] = f2bf(s_ <= t ? sc[i] : 0.f); }
            }
            LBAR();
        }
        {
            const bf16x8 vfr = trfrag(L + HG_V, lane, w, 0);
            if (MODE == 3) {
                bf16x8 sfr[4];
#pragma unroll
                for (int ks = 0; ks < 4; ++ks) sfr[ks] = trfrag(L + HG_SIMG, lane, w, ks);
#pragma unroll
                for (int mt = 0; mt < 2; ++mt) { f32x4 oacc = (f32x4){0.f, 0.f, 0.f, 0.f};
                    { const bf16x8 a = *(const PG8_LAS bf16x8*)(Aimg + (16 * mt + c) * AI_LD + 8 * q); oacc = __builtin_amdgcn_mfma_f32_16x16x32_bf16(a, vfr, oacc, 0, 0, 0); }
#pragma unroll
                    for (int ks = 0; ks < 4; ++ks) { const bf16x8 a = *(const PG8_LAS bf16x8*)(L + HG_QT + rr16(lane, mt, ks)); oacc = __builtin_amdgcn_mfma_f32_16x16x32_bf16(a, sfr[ks], oacc, 0, 0, 0); }
#pragma unroll
                    for (int i = 0; i < 4; ++i) Obuf[(16 * mt + 4 * q + i) * OB_LD + 16 * w + c] = oacc[i]; }
            }
#pragma unroll
            for (int n = 0; n < 8; ++n) { const bf16x8 kfr = trfrag(L + HG_QH, lane, n, 0);
                Sacc[n] = __builtin_amdgcn_mfma_f32_16x16x32_bf16(vfr, kfr, Sacc[n], 0, 0, 0);
                const float en = etot[16 * n + c]; Sacc[n][0] *= en; Sacc[n][1] *= en; Sacc[n][2] *= en; Sacc[n][3] *= en; }
        }
        if (MODE == 3) {
            LBAR();
#pragma unroll
            for (int n = 0; n < 8; ++n) { u32x2 wv; wv.x = pg8::cvt_pk_bf16(Sacc[n][0], Sacc[n][1]); wv.y = pg8::cvt_pk_bf16(Sacc[n][2], Sacc[n][3]);
                *(PG8_LAS u32x2*)(L + HG_SIMG + off_b(16 * n + c, 2 * w + (q >> 1)) + 8 * (q & 1)) = wv; }
            const int v0 = cg * 8;
            float o[8];
            { const f32x4 a0 = *(const PG8_LAS f32x4*)(Obuf + t1 * OB_LD + v0), a1 = *(const PG8_LAS f32x4*)(Obuf + t1 * OB_LD + v0 + 4);
              o[0] = a0[0]; o[1] = a0[1]; o[2] = a0[2]; o[3] = a0[3]; o[4] = a1[0]; o[5] = a1[1]; o[6] = a1[2]; o[7] = a1[3]; }
            bf16_t* mp = mix + (size_t)row * DM + h * 128 + v0;
            if (!combine) { *(u32x4*)mp = pack8(o); }
            else {
                float pv[8]; unpack8(cmix, pv);
                float ss = 0.f;
#pragma unroll
                for (int e = 0; e < 8; ++e) { o[e] += pv[e]; ss += o[e] * o[e]; }
                ss += __int_as_float(__builtin_amdgcn_update_dpp(0, __float_as_int(ss), 0xB1, 0xF, 0xF, true)); ss += __int_as_float(__builtin_amdgcn_update_dpp(0, __float_as_int(ss), 0x4E, 0xF, 0xF, true));
                ss += __int_as_float(__builtin_amdgcn_update_dpp(0, __float_as_int(ss), 0x141, 0xF, 0xF, true)); ss += __int_as_float(__builtin_amdgcn_update_dpp(0, __float_as_int(ss), 0x140, 0xF, 0xF, true));
                const float rs = rsqrtf(ss * (1.0f / 128.0f) + EPSV);
                float gg[8]; unpack8(cgate, gg);
                const float gn[8] = {gn0[0], gn0[1], gn0[2], gn0[3], gn1[0], gn1[1], gn1[2], gn1[3]};
                float r[8];
#pragma unroll
                for (int e = 0; e < 8; ++e) r[e] = o[e] * rs * gn[e] * (gg[e] * sigmoidf_(gg[e]));
                *(u32x4*)mp = pack8(r);
            }
        }
    }
#undef HG_LOAD
    if (MODE == 1) {
        float* st = states + ((size_t)seq * 64 + j) * 16384;
#pragma unroll
        for (int n = 0; n < 8; ++n) *(f32x4*)(st + (16 * n + c) * 128 + 16 * w + 4 * q) = Sacc[n];
        if (ts == 31) { float* dp = (float*)(P.ws + OFF_HGD) + ((size_t)seq * 64 + j) * 128 + 8 * cgs;
            *(f32x4*)dp = (f32x4){sup2[0].x, sup2[0].y, sup2[1].x, sup2[1].y}; *(f32x4*)(dp + 4) = (f32x4){sup2[2].x, sup2[2].y, sup2[3].x, sup2[3].y}; }
    }
    __syncthreads();
}

constexpr int P1_KH = 0, P1_V = 8192, P1_WTOT = 16384, P1_ETOT = 20480, P1_LB = 20992, P1_SUP = 21504, P1_STRIDE = 24576;
__device__ __forceinline__ void hg_run1x2(const Params& P, int layer, int x0, int x1, unsigned char* shm) {
    typedef float f32x2 __attribute__((ext_vector_type(2)));
    const int tid = threadIdx.x, w = tid >> 6, lane = tid & 63, c = lane & 15, q = lane >> 4;
    const int ts = lane & 31, hb = lane >> 5, cgs = 2 * w + hb;
    PG8_LAS unsigned char* L = (PG8_LAS unsigned char*)shm;
    const bf16_t* p = (const bf16_t*)(P.ws + OFF_R1);
    float* states = (float*)(P.ws + OFF_R2);
    int seq[2], jj[2], bb[2], dd[2], colz[2], colv[2];
#pragma unroll
    for (int u = 0; u < 2; ++u) { const int x = u ? x1 : x0; seq[u] = x >> 6; jj[u] = x & 63; bb[u] = seq[u] >> 3; dd[u] = seq[u] & 1; const int h = (seq[u] >> 1) & 3;
        colz[u] = 512 * (1 + dd[u]) + h * 128 + 8 * cgs; colv[u] = 1536 + h * 128 + 8 * cgs;
        if (tid < 128) { ((PG8_LAS float*)(L + u * P1_STRIDE + P1_LB))[tid] = ((const float*)(P.ws + OFF_LB))[(layer * 2 + dd[u]) * 512 + h * 128 + tid]; ((PG8_LAS float*)(L + u * P1_STRIDE + P1_SUP))[tid] = 1.0f; } }
    f32x4 Sacc[2][8];
#pragma unroll
    for (int u = 0; u < 2; ++u) {
#pragma unroll
        for (int n = 0; n < 8; ++n) Sacc[u][n] = (f32x4){0.f, 0.f, 0.f, 0.f}; }
    __syncthreads();
    const f32x2 one2 = (f32x2){1.0f, 1.0f}, nl2e = (f32x2){-1.4426950408889634f, -1.4426950408889634f}, tiny2 = (f32x2){1e-30f, 1e-30f};
    u32x4 nz[2], nv[2];
#pragma unroll
    for (int u = 0; u < 2; ++u) { const bf16_t* pr = p + (size_t)hg_row(bb[u], dd[u], jj[u], ts) * INC; nz[u] = *(const u32x4*)(pr + colz[u]); nv[u] = *(const u32x4*)(pr + colv[u]); }
#pragma unroll 1
    for (int ch = 0; ch < 8; ++ch) {
        u32x4 cz[2], cv[2];
#pragma unroll
        for (int u = 0; u < 2; ++u) { cz[u] = nz[u]; cv[u] = nv[u]; }
        if (ch < 7) {
#pragma unroll
            for (int u = 0; u < 2; ++u) { const bf16_t* pr = p + (size_t)hg_row(bb[u], dd[u], jj[u], (ch + 1) * 32 + ts) * INC; nz[u] = *(const u32x4*)(pr + colz[u]); nv[u] = *(const u32x4*)(pr + colv[u]); } }
        u32x4 khp[2]; f32x2 tot2[2][4];
#pragma unroll
        for (int u = 0; u < 2; ++u) { float zf[8]; unpack8(cz[u], zf); float kh[8]; f32x2 g2u[4], kk2u[4];
#pragma unroll
            for (int e2 = 0; e2 < 4; ++e2) { const f32x2 nzz = (f32x2){zf[2 * e2], zf[2 * e2 + 1]} * nl2e;
                const f32x2 t = (f32x2){__builtin_amdgcn_exp2f(nzz.x), __builtin_amdgcn_exp2f(nzz.y)} + one2;
                const f32x2 inv = (f32x2){__builtin_amdgcn_rcpf(t.x), __builtin_amdgcn_rcpf(t.y)};
                const f32x2 lbp2 = *(const PG8_LAS f32x2*)(L + u * P1_STRIDE + P1_LB + (8 * cgs + 2 * e2) * 4); const f32x2 oml = one2 - lbp2;
                g2u[e2] = lbp2 + oml * inv; kk2u[e2] = oml - oml * inv; }
            { float s0 = g2u[0].x, s1 = g2u[0].y, s2 = g2u[1].x, s3 = g2u[1].y, s4 = g2u[2].x, s5 = g2u[2].y, s6 = g2u[3].x, s7 = g2u[3].y;
              scan32_prod8(s0, s1, s2, s3, s4, s5, s6, s7);
              g2u[0] = (f32x2){s0, s1}; g2u[1] = (f32x2){s2, s3}; g2u[2] = (f32x2){s4, s5}; g2u[3] = (f32x2){s6, s7}; }
#pragma unroll
            for (int e2 = 0; e2 < 4; ++e2) { tot2[u][e2] = g2u[e2];
                const f32x2 cm = __builtin_elementwise_max(g2u[e2], tiny2);
                const f32x2 k2 = kk2u[e2] * (f32x2){__builtin_amdgcn_rcpf(cm.x), __builtin_amdgcn_rcpf(cm.y)};
                kh[2 * e2] = k2.x; kh[2 * e2 + 1] = k2.y; }
            khp[u] = pack8(kh); }
        LBAR();
#pragma unroll
        for (int u = 0; u < 2; ++u) {
            PG8_LAS float* etot = (PG8_LAS float*)(L + u * P1_STRIDE + P1_ETOT);
            const unsigned ob = off_b(ts, cgs);
            *(PG8_LAS u32x4*)(L + u * P1_STRIDE + P1_KH + ob) = khp[u];
            *(PG8_LAS u32x4*)(L + u * P1_STRIDE + P1_V + ob) = cv[u];
            if (ts == 31) { const f32x4 e0 = (f32x4){tot2[u][0].x, tot2[u][0].y, tot2[u][1].x, tot2[u][1].y}, e1 = (f32x4){tot2[u][2].x, tot2[u][2].y, tot2[u][3].x, tot2[u][3].y};
                *(PG8_LAS f32x4*)(etot + 8 * cgs) = e0; *(PG8_LAS f32x4*)(etot + 8 * cgs + 4) = e1;
                PG8_LAS f32x4* sp = (PG8_LAS f32x4*)(L + u * P1_STRIDE + P1_SUP + 8 * cgs * 4); sp[0] = sp[0] * e0; sp[1] = sp[1] * e1; } }
        LBAR();
#pragma unroll
        for (int u = 0; u < 2; ++u) {
            PG8_LAS float* etot = (PG8_LAS float*)(L + u * P1_STRIDE + P1_ETOT);
            const bf16x8 vfr = trfrag(L + u * P1_STRIDE + P1_V, lane, w, 0);
#pragma unroll
            for (int n = 0; n < 8; ++n) { const bf16x8 kfr = trfrag(L + u * P1_STRIDE + P1_KH, lane, n, 0);
                Sacc[u][n] = __builtin_amdgcn_mfma_f32_16x16x32_bf16(vfr, kfr, Sacc[u][n], 0, 0, 0);
                const float en = etot[16 * n + c]; Sacc[u][n][0] *= en; Sacc[u][n][1] *= en; Sacc[u][n][2] *= en; Sacc[u][n][3] *= en; } }
    }
#pragma unroll
    for (int u = 0; u < 2; ++u) {
        float* st = states + ((size_t)seq[u] * 64 + jj[u]) * 16384;
#pragma unroll
        for (int n = 0; n < 8; ++n) *(f32x4*)(st + (16 * n + c) * 128 + 16 * w + 4 * q) = Sacc[u][n];
        if (ts == 31) { float* dp = (float*)(P.ws + OFF_HGD) + ((size_t)seq[u] * 64 + jj[u]) * 128 + 8 * cgs; const PG8_LAS f32x4* sp = (const PG8_LAS f32x4*)(L + u * P1_STRIDE + P1_SUP + 8 * cgs * 4);
            const f32x4 s0 = sp[0], s1 = sp[1]; *(f32x4*)dp = s0; *(f32x4*)(dp + 4) = s1; } }
    __syncthreads();
}

__device__ __forceinline__ float gelu_tanh(float x) { const float u = 0.7978845608028654f * (x + 0.044715f * x * x * x); const float e = __expf(2.0f * u); const float th = 1.0f - 2.0f * __builtin_amdgcn_rcpf(e + 1.0f); return 0.5f * x * (1.0f + th); }

template <int MODE  >
__device__ __forceinline__ void rg_item(const Params& P, int layer, int b, int ci, unsigned char* shm) {
    const int tid = threadIdx.x, w = tid >> 6, lane = tid & 63, c = lane & 15, q = lane >> 4, cg = lane & 7, tq = lane >> 3;
    PG8_LAS unsigned char* U = (PG8_LAS unsigned char*)shm + w * 16384;
    PG8_LAS unsigned char* Ut = U + 8192;
    const bf16_t* p = (const bf16_t*)(P.ws + OFF_R1);
    bf16_t* mix = (bf16_t*)(P.ws + OFF_R3);
    float* agg = (float*)(P.ws + OFF_RGAGG);
    const bool isctx = ci < 4;
    const int T0 = isctx ? ci * 64 : (ci - 4) * 64;
    const int rowbase = isctx ? NLAT + b * 256 : b * 16384;
    const int seglo = isctx ? 0 : T0, seghi = isctx ? 256 : T0 + 64;
    {
        u32x4 raw[11];
        const bf16_t* pc = p + (size_t)rowbase * INC + 2560 + 64 * w + 8 * cg;
#pragma unroll
        for (int x = 0; x < 11; ++x) { const int tok = T0 + 8 * tq - 2 + x; raw[x] = (tok >= seglo && tok < seghi) ? *(const u32x4*)(pc + (size_t)tok * INC) : (u32x4){0u, 0u, 0u, 0u}; }
        float cw[4][8], o[8][8];
        { const float* cwp = P.in[10] + (size_t)layer * 4 * 512 + 64 * w + 8 * cg;
#pragma unroll
          for (int jx = 0; jx < 4; ++jx) { const float4 a0 = *(const float4*)(cwp + jx * 512), a1 = *(const float4*)(cwp + jx * 512 + 4);
              cw[jx][0] = a0.x; cw[jx][1] = a0.y; cw[jx][2] = a0.z; cw[jx][3] = a0.w; cw[jx][4] = a1.x; cw[jx][5] = a1.y; cw[jx][6] = a1.z; cw[jx][7] = a1.w; }
          const float* cbp = P.in[11] + layer * 512 + 64 * w + 8 * cg; const float4 b0 = *(const float4*)cbp, b1 = *(const float4*)(cbp + 4);
#pragma unroll
          for (int k = 0; k < 8; ++k) { o[k][0] = b0.x; o[k][1] = b0.y; o[k][2] = b0.z; o[k][3] = b0.w; o[k][4] = b1.x; o[k][5] = b1.y; o[k][6] = b1.z; o[k][7] = b1.w; } }
#pragma unroll
        for (int x = 0; x < 11; ++x) { float f[8]; unpack8(raw[x], f);
#pragma unroll
            for (int jx = 0; jx < 4; ++jx) { const int k = x - jx; if (k >= 0 && k < 8) {
#pragma unroll
                for (int e = 0; e < 8; ++e) o[k][e] += cw[jx][e] * f[e]; } } }
#pragma unroll
        for (int k = 0; k < 8; ++k) { const int tau = 8 * tq + k; *(PG8_LAS u32x4*)(U + tau * 128 + ((cg ^ (tau & 7)) << 4)) = pack8(o[k]); }
#pragma unroll
        for (int e = 0; e < 8; ++e) { const int chn = 8 * cg + e; float vv[8];
#pragma unroll
            for (int k = 0; k < 8; ++k) vv[k] = o[k][e];
            *(PG8_LAS u32x4*)(Ut + chn * 128 + ((tq ^ (chn & 7)) << 4)) = pack8(vv); }
    }
    bf16x8 Af[4][2];
#pragma unroll
    for (int m = 0; m < 4; ++m)
#pragma unroll
        for (int kk = 0; kk < 2; ++kk) { const int tau = 16 * (c >> 2) + 4 * m + (c & 3); const int lc = 4 * kk + q; Af[m][kk] = *(const PG8_LAS bf16x8*)(U + tau * 128 + ((lc ^ (tau & 7)) << 4)); }
#pragma unroll
    for (int d = 0; d < 2; ++d) {
        const u32x4* wf = (const u32x4*)(P.ws + OFF_WF) + (size_t)((layer * 2 + d) * 8 + w) * 1024 + lane;
        const int csd = d == 0 ? ci : (isctx ? 3 - ci : 4 + (259 - ci));
        float* ag = agg + (size_t)((d * 2 + b) * 260 + csd) * 1024;
        u32x4 n_wa0, n_wa1, n_wx0, n_wx1; float n_ba, n_bx, n_lam, n_h0 = 0.f;
#define RG_LOAD(NT) do { const int ch_ = 64 * w + 16 * (NT) + c; \
            n_wa0 = wf[((0 * 4 + (NT)) * 2 + 0) * 64]; n_wa1 = wf[((0 * 4 + (NT)) * 2 + 1) * 64]; n_wx0 = wf[((1 * 4 + (NT)) * 2 + 0) * 64]; n_wx1 = wf[((1 * 4 + (NT)) * 2 + 1) * 64]; \
            n_ba = P.in[13][(layer * 2 + d) * 512 + ch_]; n_bx = P.in[15][(layer * 2 + d) * 512 + ch_]; n_lam = P.in[16][(layer * 2 + d) * 512 + ch_]; \
            if (MODE == 1) n_h0 = ag[ch_]; \
            } while (0)
        RG_LOAD(0);
#pragma unroll 1
        for (int nt = 0; nt < 4; ++nt) {
            const int chl = 16 * nt + c, ch = 64 * w + chl;
            const u32x4 wa0 = n_wa0, wa1 = n_wa1, wx0 = n_wx0, wx1 = n_wx1;
            const float bav = n_ba, bxv = n_bx, lam = n_lam;
            const float h0 = n_h0;
            if (nt < 3) RG_LOAD(nt + 1);
            const float c8 = -8.0f * log1pf(__expf(-lam));
            f32x4 ar[4], ax[4];
#pragma unroll
            for (int m = 0; m < 4; ++m) { ar[m] = (f32x4){0.f, 0.f, 0.f, 0.f}; ax[m] = (f32x4){0.f, 0.f, 0.f, 0.f};
                ar[m] = __builtin_amdgcn_mfma_f32_16x16x32_bf16(Af[m][0], __builtin_bit_cast(bf16x8, wa0), ar[m], 0, 0, 0); ar[m] = __builtin_amdgcn_mfma_f32_16x16x32_bf16(Af[m][1], __builtin_bit_cast(bf16x8, wa1), ar[m], 0, 0, 0);
                ax[m] = __builtin_amdgcn_mfma_f32_16x16x32_bf16(Af[m][0], __builtin_bit_cast(bf16x8, wx0), ax[m], 0, 0, 0); ax[m] = __builtin_amdgcn_mfma_f32_16x16x32_bf16(Af[m][1], __builtin_bit_cast(bf16x8, wx1), ax[m], 0, 0, 0); }
            float uf[16];
            { const u32x4 u0 = *(const PG8_LAS u32x4*)(Ut + chl * 128 + (((2 * q) ^ (chl & 7)) << 4)), u1 = *(const PG8_LAS u32x4*)(Ut + chl * 128 + (((2 * q + 1) ^ (chl & 7)) << 4));
              unpack8(u0, uf); unpack8(u1, uf + 8); }
            float av[16], hv[16];
            {
                typedef float f32x2 __attribute__((ext_vector_type(2)));
                const float nba = bav * -1.4426950408889634f, nbx = bxv * -1.4426950408889634f, c8l = c8 * 1.4426950408889634f;
                const f32x2 nba2 = (f32x2){nba, nba}, nbx2 = (f32x2){nbx, nbx}, one2 = (f32x2){1.0f, 1.0f}, c82 = (f32x2){c8l, c8l};
#pragma unroll
                for (int m = 0; m < 4; ++m)
#pragma unroll
                    for (int pr = 0; pr < 2; ++pr) { const int kp = 4 * m + 2 * pr;
                        const f32x2 na = (f32x2){ar[m][2 * pr], ar[m][2 * pr + 1]} + nba2, nx = (f32x2){ax[m][2 * pr], ax[m][2 * pr + 1]} + nbx2;
                        f32x2 t1 = (f32x2){__builtin_amdgcn_exp2f(na.x), __builtin_amdgcn_exp2f(na.y)} + one2, t2 = (f32x2){__builtin_amdgcn_exp2f(nx.x), __builtin_amdgcn_exp2f(nx.y)} + one2;
                        const f32x2 r = (f32x2){__builtin_amdgcn_rcpf(t1.x), __builtin_amdgcn_rcpf(t1.y)}, ig = (f32x2){__builtin_amdgcn_rcpf(t2.x), __builtin_amdgcn_rcpf(t2.y)};
                        const f32x2 la = r * c82; const f32x2 a = (f32x2){__builtin_amdgcn_exp2f(la.x), __builtin_amdgcn_exp2f(la.y)};
                        const f32x2 om = one2 - a * a;
                        const f32x2 mult = (f32x2){__builtin_amdgcn_sqrtf(om.x), __builtin_amdgcn_sqrtf(om.y)};
                        const f32x2 hh = mult * ig * (f32x2){uf[kp], uf[kp + 1]};
                        av[kp] = a.x; av[kp + 1] = a.y; hv[kp] = hh.x; hv[kp + 1] = hh.y; }
            }
            { float hl = 0.f, cp = 1.f;
#pragma unroll
              for (int kk2 = 0; kk2 < 16; ++kk2) { const int kp = d ? 15 - kk2 : kk2; hl = av[kp] * hl + hv[kp]; cp *= av[kp]; hv[kp] = hl; av[kp] = cp; } }
            const float Aq = d ? av[0] : av[15], Hq = d ? hv[0] : hv[15];
            const float A0 = __shfl(Aq, c), A1 = __shfl(Aq, c + 16), A2 = __shfl(Aq, c + 32), A3 = __shfl(Aq, c + 48);
            const float H0 = __shfl(Hq, c), H1 = __shfl(Hq, c + 16), H2 = __shfl(Hq, c + 32), H3 = __shfl(Hq, c + 48);
            if (MODE == 0) {
                if (q == 0) { float Pt, Ht;
                    if (d == 0) { Pt = (A0 * A1) * (A2 * A3); Ht = ((H0 * A1 + H1) * A2 + H2) * A3 + H3; }
                    else { Pt = (A0 * A1) * (A2 * A3); Ht = ((H3 * A2 + H2) * A1 + H1) * A0 + H0; }
                    ag[ch] = Pt; ag[512 + ch] = Ht; }
            } else {
                float hin = h0;
                if (d == 0) { if (q >= 1) hin = A0 * hin + H0; if (q >= 2) hin = A1 * hin + H1; if (q >= 3) hin = A2 * hin + H2; }
                else { if (q <= 2) hin = A3 * hin + H3; if (q <= 1) hin = A2 * hin + H2; if (q <= 0) hin = A1 * hin + H1; }
                PG8_LAS unsigned char* hp0 = U + chl * 128 + (((2 * q) ^ (chl & 7)) << 4); PG8_LAS unsigned char* hp1 = U + chl * 128 + (((2 * q + 1) ^ (chl & 7)) << 4);
                if (d == 0) {
#pragma unroll
                    for (int kp = 0; kp < 16; ++kp) hv[kp] = hv[kp] + av[kp] * hin;
                    *(PG8_LAS u32x4*)hp0 = pack8(hv); *(PG8_LAS u32x4*)hp1 = pack8(hv + 8);
                } else {
                    float hfw[16]; unpack8(*(const PG8_LAS u32x4*)hp0, hfw); unpack8(*(const PG8_LAS u32x4*)hp1, hfw + 8);
#pragma unroll
                    for (int kp = 0; kp < 16; ++kp) hv[kp] = hfw[kp] + (hv[kp] + av[kp] * hin);
                    *(PG8_LAS u32x4*)hp0 = pack8(hv); *(PG8_LAS u32x4*)hp1 = pack8(hv + 8);
                }
            }
        }
#undef RG_LOAD
    }
    if (MODE == 1) {
        u32x4 gva[8];
#pragma unroll
        for (int k = 0; k < 8; ++k) gva[k] = *(const u32x4*)(p + (size_t)(rowbase + T0 + 8 * tq + k) * INC + 3072 + 64 * w + 8 * cg);
#pragma unroll
        for (int half = 0; half < 2; ++half) {
            u32x4 gv[4];
#pragma unroll
            for (int k = 0; k < 4; ++k) gv[k] = gva[4 * half + k];
            float val[8][4];
#pragma unroll
            for (int e = 0; e < 8; ++e) { const int chn = 8 * cg + e; const u32x2 hvv = *(const PG8_LAS u32x2*)(U + chn * 128 + ((tq ^ (chn & 7)) << 4) + 8 * half);
                val[e][0] = __uint_as_float(hvv.x << 16); val[e][1] = __uint_as_float(hvv.x & 0xffff0000u); val[e][2] = __uint_as_float(hvv.y << 16); val[e][3] = __uint_as_float(hvv.y & 0xffff0000u); }
#pragma unroll
            for (int k = 0; k < 4; ++k) { float g[8], o[8]; unpack8(gv[k], g);
#pragma unroll
                for (int e = 0; e < 8; ++e) o[e] = val[e][k] * gelu_tanh(g[e]);
                *(u32x4*)(mix + (size_t)(rowbase + T0 + 8 * tq + 4 * half + k) * DM + 512 + 64 * w + 8 * cg) = pack8(o); }
        }
    }
}

__device__ __forceinline__ void phase_mix1(const Params& P, int layer, unsigned char* shm) {
#ifndef MK_REP
#define MK_REP 0
#endif
    for (int rep = 0; rep < ((MK_REP & 1) ? 2 : 1); ++rep)
    for (int it = blockIdx.x; it < 520; it += gridDim.x) rg_item<0>(P, layer, it / 260, it % 260, shm);
    __syncthreads();
    { const int xa = (blockIdx.x + 248) % gridDim.x;
      int x = xa;
      for (; x + (int)gridDim.x < 1024; x += 2 * gridDim.x) hg_run1x2(P, layer, x, x + gridDim.x, shm);
      for (; x < 1024; x += gridDim.x) { const int seq = x >> 6, j = x & 63; hg_run<1>(P, layer, seq >> 3, (seq >> 1) & 3, seq & 1, j, false, shm); } }
}
__device__ __forceinline__ void phase_mix2(const Params& P, unsigned char* shm) {
    const int tid = threadIdx.x;
    float* lagg = (float*)shm;
    for (int it = blockIdx.x; it < 16 + 512; it += gridDim.x) {
        if (it < 16) {
            const int db = it >> 2, cl = tid & 127, g = tid >> 7, cch = (it & 3) * 128 + cl;
            float* ag = (float*)(P.ws + OFF_RGAGG) + (size_t)db * 260 * 1024 + cch + (size_t)g * 65 * 1024;
            float Pg = 1.f, Hg = 0.f;
            { const float* agp = ag;
#pragma unroll 1
            for (int s0 = 0; s0 < 5; ++s0, agp += 13 * 1024) {
                float Pv[13], Hv[13];
#pragma unroll
                for (int u = 0; u < 13; ++u) { Pv[u] = agp[u * 1024]; Hv[u] = agp[u * 1024 + 512]; }
#pragma unroll
                for (int u = 0; u < 13; ++u) { Hg = Pv[u] * Hg + Hv[u]; Pg *= Pv[u]; }
            } }
            lagg[g * 128 + cl] = Pg; lagg[512 + g * 128 + cl] = Hg;
            __syncthreads();
            float h = 0.f;
            for (int gg = 0; gg < g; ++gg) h = lagg[gg * 128 + cl] * h + lagg[512 + gg * 128 + cl];
            { float* agp = ag;
#pragma unroll 1
            for (int s0 = 0; s0 < 5; ++s0, agp += 13 * 1024) {
                float Pv[13], Hv[13];
#pragma unroll
                for (int u = 0; u < 13; ++u) { Pv[u] = agp[u * 1024]; Hv[u] = agp[u * 1024 + 512]; }
#pragma unroll
                for (int u = 0; u < 13; ++u) { agp[u * 1024] = h; h = Pv[u] * h + Hv[u]; }
            } }
            __syncthreads();
        } else {
            const int x = it - 16; const int seq = x >> 5; const int e = (x & 31) * 512 + tid; const int k = e >> 7;
            float* st = (float*)(P.ws + OFF_R2) + (size_t)seq * 64 * 16384 + e; const float* dd = (const float*)(P.ws + OFF_HGD) + (size_t)seq * 64 * 128 + k;
            float S = 0.f;
            float Ln[16], Dn[16];
#pragma unroll
            for (int u = 0; u < 16; ++u) { Ln[u] = st[(size_t)u * 16384]; Dn[u] = dd[u * 128]; }
#pragma unroll 1
            for (int s0 = 0; s0 < 4; ++s0, st += 16 * 16384, dd += 16 * 128) {
                float Lv[16], Dv[16];
#pragma unroll
                for (int u = 0; u < 16; ++u) { Lv[u] = Ln[u]; Dv[u] = Dn[u]; }
                if (s0 < 3) {
#pragma unroll
                    for (int u = 0; u < 16; ++u) { Ln[u] = st[(size_t)(16 + u) * 16384]; Dn[u] = dd[(16 + u) * 128]; } }
#pragma unroll
                for (int u = 0; u < 16; ++u) { S = Dv[u] * S + Lv[u]; st[(size_t)u * 16384] = S; }
            }
        }
    }
}
__device__ __forceinline__ void phase_mix3(const Params& P, int layer, unsigned char* shm) {
    const bool wc = layer == 0;
    const int nrg = wc ? 520 : 512, nj = wc ? 65 : 64, nhg = 8 * nj;
    const int x0 = (blockIdx.x + 248) % gridDim.x;
    const bool rg_skip = wc && gridDim.x == 256 && x0 < 8;
    const int rg_first = (wc && gridDim.x == 256) ? (blockIdx.x < 8 ? (int)blockIdx.x : (int)blockIdx.x - 8) : (int)blockIdx.x;
    const int rg_stride = (wc && gridDim.x == 256) ? 248 : (int)gridDim.x;
    if (!rg_skip)
    for (int it = rg_first; it < nrg; it += rg_stride) { const int per = wc ? 260 : 256; const int b = it / per, ci = (it % per) + (wc ? 0 : 4); rg_item<1>(P, layer, b, ci, shm); }
    __syncthreads();
    for (int rep = 0; rep < ((MK_REP & 8) ? 2 : 1); ++rep)
    for (int x = (blockIdx.x + 248) % gridDim.x; x < nhg; x += gridDim.x) { const int bh = x / nj, j = (x % nj) + (wc ? 0 : 1); const int b = bh >> 2, h = bh & 3;
#pragma unroll 1
        for (int dir = 0; dir < 2; ++dir) hg_run<3>(P, layer, b, h, dir, (dir == 0 || j == 0) ? j : 65 - j, dir == 1, shm); }
}

template <class Epi>
__device__ __forceinline__ void phase_gemm(const bf16_t* A, const bf16_t* Bt, int M, int N, int K, const Epi& E, unsigned char* shm) {
    pg8::Gemm g; g.A = A; g.Bt = Bt; g.M = M; g.N = N; g.K = K;
    pg8::StaticOrder S; S.init(M, N, (int)gridDim.x, (int)blockIdx.x);
#ifndef MK_GEMM_ALIGN
#define MK_GEMM_ALIGN true
#endif
#ifndef MK_GEMM_SP2
#define MK_GEMM_SP2 true
#endif
    pg8::gemm_phase<Epi, pg8::StaticOrder, MK_GEMM_ALIGN, MK_GEMM_SP2>((PG8_LAS unsigned char*)shm, g, S, E);
}

template <int K>
__device__ __forceinline__ void ctx_gemm_small(const bf16_t* __restrict__ A, const bf16_t* __restrict__ Bt, bf16_t* __restrict__ Y, unsigned char* shm) {
    const int tid = threadIdx.x, w = tid >> 6, lane = tid & 63, c = lane & 15, q = lane >> 4;
    PG8_LAS float* red = (PG8_LAS float*)shm;
    constexpr int KW = K / 8;
    for (int job = blockIdx.x; job < 256; job += gridDim.x) {
        const int row0 = (job >> 4) * 32, col0 = (job & 15) * 64;
        f32x4 acc[2][4];
#pragma unroll
        for (int mt = 0; mt < 2; ++mt)
#pragma unroll
            for (int nt = 0; nt < 4; ++nt) acc[mt][nt] = (f32x4){0.f, 0.f, 0.f, 0.f};
        const bf16_t* ap = A + (size_t)(row0 + c) * K + w * KW + 8 * q;
        const bf16_t* bp = Bt + (size_t)(col0 + c) * K + w * KW + 8 * q;
#pragma unroll 2
        for (int ks = 0; ks < KW / 32; ++ks) {
            bf16x8 a[2], b[4];
#pragma unroll
            for (int mt = 0; mt < 2; ++mt) a[mt] = *(const bf16x8*)(ap + (size_t)(16 * mt) * K + 32 * ks);
#pragma unroll
            for (int nt = 0; nt < 4; ++nt) b[nt] = *(const bf16x8*)(bp + (size_t)(16 * nt) * K + 32 * ks);
#pragma unroll
            for (int mt = 0; mt < 2; ++mt)
#pragma unroll
                for (int nt = 0; nt < 4; ++nt) acc[mt][nt] = __builtin_amdgcn_mfma_f32_16x16x32_bf16(a[mt], b[nt], acc[mt][nt], 0, 0, 0);
        }
#pragma unroll
        for (int mt = 0; mt < 2; ++mt)
#pragma unroll
            for (int nt = 0; nt < 4; ++nt)
#pragma unroll
                for (int i = 0; i < 4; ++i) red[w * 2048 + (16 * mt + 4 * q + i) * 64 + 16 * nt + c] = acc[mt][nt][i];
        __syncthreads();
        { const int idx = tid * 4, r = idx >> 6, cc = idx & 63;
          f32x4 sum = (f32x4){0.f, 0.f, 0.f, 0.f};
#pragma unroll
          for (int ww = 0; ww < 8; ++ww) sum += *(const PG8_LAS f32x4*)(red + ww * 2048 + idx);
          u32x2 o; o.x = pg8::cvt_pk_bf16(sum[0], sum[1]); o.y = pg8::cvt_pk_bf16(sum[2], sum[3]);
          *(u32x2*)(Y + (size_t)(row0 + r) * 1024 + col0 + cc) = o; }
        __syncthreads();
    }
}

#define XB_TMO      128
#define XB_XCNT(j)  (256  + 64 * (j))
#define XB_XSUB(j)  (1280 + 64 * (j))
#define XB_XGEN(j)  (2304 + 64 * (j))
#define XB_TOP      3328
#define XB_TOPGEN   3392
#define XCD_BAR_WORDS 3456
#define XB_SPIN_CAP (1u << 18)
#define XB_LAS __attribute__((address_space(3)))

__device__ __forceinline__ unsigned xb_ld(unsigned* p)              { return __hip_atomic_load(p, __ATOMIC_RELAXED, __HIP_MEMORY_SCOPE_AGENT); }
__device__ __forceinline__ unsigned xb_add(unsigned* p, unsigned v) { return __hip_atomic_fetch_add(p, v, __ATOMIC_RELAXED, __HIP_MEMORY_SCOPE_AGENT); }
__device__ __forceinline__ unsigned xb_xcc_id() { return (unsigned)__builtin_amdgcn_s_getreg((3 << 11) | 20) & 0xFu; }
#define XB_SPIN(cond, bar) do { unsigned _sp = 0; while (cond) { __builtin_amdgcn_s_sleep(1); \
    if ((++_sp & 255u) == 0u) { if (xb_ld(&(bar)[XB_TMO])) break; if (_sp > XB_SPIN_CAP) { atomicAdd(&(bar)[XB_TMO], 1u); break; } } } } while (0)

struct XcdBarrier {
    unsigned* bar; unsigned x;
    volatile XB_LAS unsigned* st;
};

__device__ __forceinline__ XcdBarrier xcd_barrier_post(unsigned* bar, volatile XB_LAS unsigned* st) {
    XcdBarrier b; b.bar = bar; b.x = xb_xcc_id(); b.st = st;
    if (threadIdx.x == 0) (void)xb_add(&bar[XB_XCNT(b.x)], 1u);
    return b;
}
__device__ __forceinline__ void xcd_barrier_complete(unsigned* bar, unsigned x, unsigned& nloc, unsigned& nx) {
    const unsigned G = gridDim.x * gridDim.y * gridDim.z;
    unsigned sum, cnt, mine, sp = 0u;
    for (;;) {
        sum = 0u; cnt = 0u; mine = 0u;
#pragma unroll
        for (unsigned j = 0; j < 16; ++j) { const unsigned c = xb_ld(&bar[XB_XCNT(j)]); sum += c; cnt += (c > 0u) ? 1u : 0u; mine = (j == x) ? c : mine; }
        if (sum == G) break;
        __builtin_amdgcn_s_sleep(1);
        if ((++sp & 255u) == 0u) { if (xb_ld(&bar[XB_TMO])) break; if (sp > XB_SPIN_CAP) { atomicAdd(&bar[XB_TMO], 1u); break; } }
    }
    nloc = mine > 0u ? mine : 1u; nx = cnt > 0u ? cnt : 1u;
}

__device__ __forceinline__ void xcd_barrier(const XcdBarrier& b) {
    asm volatile("s_waitcnt vmcnt(0)" ::: "memory");
    __syncthreads();
    if (threadIdx.x == 0) {
        unsigned* bar = b.bar;
        __builtin_amdgcn_s_waitcnt(0);
        unsigned nloc = b.st[0], nx = b.st[1];
        if (nloc == 0u) { xcd_barrier_complete(bar, b.x, nloc, nx); b.st[0] = nloc; b.st[1] = nx; }
        const unsigned old = xb_add(&bar[XB_XSUB(b.x)], 1u);
        const unsigned gen = old / nloc;
        if (old + 1u == (gen + 1u) * nloc) {
            __builtin_amdgcn_fence(__ATOMIC_RELEASE, "agent");
            asm volatile("s_waitcnt vmcnt(0)" ::: "memory");
            const unsigned og = xb_add(&bar[XB_TOP], 1u);
            const unsigned tg = og / nx;
            if (og + 1u == (tg + 1u) * nx) xb_add(&bar[XB_TOPGEN], 1u);
            else XB_SPIN(xb_ld(&bar[XB_TOPGEN]) == tg, bar);
            __builtin_amdgcn_fence(__ATOMIC_ACQUIRE, "agent");
            xb_add(&bar[XB_XGEN(b.x)], 1u);
            asm volatile("s_waitcnt vmcnt(0)" ::: "memory");
        } else {
            XB_SPIN(xb_ld(&bar[XB_XGEN(b.x)]) == gen, bar);
            __builtin_amdgcn_fence(__ATOMIC_ACQUIRE, "agent");
            asm volatile("s_waitcnt vmcnt(0)" ::: "memory");
        }
    }
    __syncthreads();
}

constexpr int N_PHASES = 20;
template <int ph> __device__ __forceinline__ void run_phase(const Params& P, unsigned char* shm) {
    unsigned char* ws = P.ws;
    const float* mods = (const float*)(ws + OFF_MODS);
    bf16_t* hA = (bf16_t*)(ws + OFF_R2); bf16_t* pbuf = (bf16_t*)(ws + OFF_R1); bf16_t* mix = (bf16_t*)(ws + OFF_R3); bf16_t* ybuf = (bf16_t*)(ws + OFF_R2); bf16_t* xb = (bf16_t*)(ws + OFF_R4); bf16_t* hid = (bf16_t*)(ws + OFF_R1);
    float* xctx = (float*)(ws + OFF_XCTX);
    if constexpr (ph == 0) { phase_prep(P, shm); return; }
    else if constexpr (ph == 1) {
        RowOp R; R.xs_lat = P.in[0]; R.xs_ctx = P.in[2]; R.xd_lat = P.out; R.xd_ctx = xctx; R.xs_lat_b = (const bf16_t*)(ws + OFF_R4); R.xd_lat_b = (bf16_t*)(ws + OFF_R4); R.y = nullptr; R.yw = nullptr; R.mods_y = nullptr; R.gate_idx = 0;
        R.hdst = hA; R.hw = P.in[6]; R.mods_h = mods; R.shift_idx = 0; R.scale_idx = 1; R.nrows = NROWS;
        phase_rowop<false, false>(R, shm);
        convert_tiles(P, shm, 896, 6528); return;
    } else {
    constexpr int layer = (ph - 2) / 9, sub = (ph - 2) % 9;
    constexpr bool last = layer == 1;
    constexpr int Mrows = last ? NLAT : NROWS;
    const float* ng = P.in[6] + (size_t)layer * 4 * 1024;
    const float* lmods = mods + (size_t)layer * 3 * 6144;
    if constexpr (sub == 0) { pg8::EpiBf16<0> E; E.O = pbuf; E.ldc = INC; E.bias = nullptr; E.split_cols = 0; E.split_stride = 0;
              phase_gemm(hA, (const bf16_t*)(ws + OFF_WIN + layer * SZ_WIN), NROWS, INC, DM, E, shm); }
    else if constexpr (sub == 1) { phase_mix1(P, layer, shm); }
    else if constexpr (sub == 2) { phase_mix2(P, shm); }
    else if constexpr (sub == 3) { phase_mix3(P, layer, shm); }
    else if constexpr (sub == 4) { { pg8::EpiBf16<0> E; E.O = ybuf; E.ldc = DM; E.bias = nullptr; E.split_cols = 0; E.split_stride = 0;
              phase_gemm(mix, (const bf16_t*)(ws + OFF_WOUT + layer * SZ_WOUT), NLAT, DM, DM, E, shm);
              if (!last) ctx_gemm_small<DM>(mix + (size_t)NLAT * DM, (const bf16_t*)(ws + OFF_WOUT + layer * SZ_WOUT), ybuf + (size_t)NLAT * DM, shm); } }
    else if constexpr (sub == 5) { { RowOp R; R.xs_lat = P.in[0]; R.xs_lat_b = xb; R.xs_ctx = layer == 0 ? P.in[2] : xctx; R.xd_lat = P.out; R.xd_lat_b = xb; R.xd_ctx = xctx;
              R.y = ybuf; R.yw = ng + 1024; R.mods_y = lmods; R.gate_idx = 2;
              R.hdst = hA; R.hw = ng + 2048; R.mods_h = lmods; R.shift_idx = 3; R.scale_idx = 4; R.nrows = Mrows;
              phase_rowop<(layer != 0), true>(R, shm); } }
    else if constexpr (sub == 6) { { EpiSwiglu E; E.O = hid; E.ldc = DFF;
              phase_gemm(hA, (const bf16_t*)(ws + OFF_WGU + layer * SZ_WGU), Mrows, NGU, DM, E, shm); } }
    else if constexpr (sub == 7) { { bf16_t* ybuf2 = mix; pg8::EpiBf16<0> E; E.O = ybuf2; E.ldc = DM; E.bias = nullptr; E.split_cols = 0; E.split_stride = 0;
              phase_gemm(hid, (const bf16_t*)(ws + OFF_WDN + layer * SZ_WDN), NLAT, DM, DFF, E, shm);
              if (!last) ctx_gemm_small<DFF>(hid + (size_t)NLAT * DFF, (const bf16_t*)(ws + OFF_WDN + layer * SZ_WDN), ybuf2 + (size_t)NLAT * DM, shm); } }
    else if constexpr (sub == 8) { { RowOp R; R.xs_lat = P.in[0]; R.xs_lat_b = xb; R.xs_ctx = xctx; R.xd_lat = P.out; R.xd_lat_b = xb; R.xd_ctx = xctx;
              R.y = mix; R.yw = ng + 3072; R.mods_y = lmods; R.gate_idx = 5;
              if (!last) { R.hdst = hA; R.hw = P.in[6] + (size_t)(layer + 1) * 4 * 1024; R.mods_h = mods + (size_t)(layer + 1) * 3 * 6144; R.shift_idx = 0; R.scale_idx = 1; }
              else { R.hdst = nullptr; R.hw = nullptr; R.mods_h = nullptr; R.shift_idx = 0; R.scale_idx = 0; }
              R.nrows = Mrows;
              phase_rowop<true, !last>(R, shm); } }
    }
}

__global__ __launch_bounds__(512, 2) void mk_fwd(Params P, int ph_lo, int ph_hi) {
    extern __shared__ __attribute__((aligned(16))) unsigned char shm[];
    __shared__ uint4 xb_words;
    cg::grid_group grid = cg::this_grid();
    if (ph_hi < 0) grid.sync();
    if (threadIdx.x == 0) xb_words = make_uint4(0u, 0u, 0u, 0u);
    __syncthreads();
    XcdBarrier xb = xcd_barrier_post((unsigned*)(P.ws + OFF_BAR), (volatile XB_LAS unsigned*)&xb_words);
#ifndef MK_REPEAT_MASK
#define MK_REPEAT_MASK 0u
#endif
#define MK_PHASE(k) if (ph_lo <= (k) && (k) < ph_hi) { if ((k) > ph_lo) xcd_barrier(xb); run_phase<(k)>(P, shm); if constexpr ((MK_REPEAT_MASK >> (k)) & 1u) { xcd_barrier(xb); run_phase<(k)>(P, shm); } }
    MK_PHASE(0) MK_PHASE(1) MK_PHASE(2) MK_PHASE(3) MK_PHASE(4) MK_PHASE(5) MK_PHASE(6) MK_PHASE(7) MK_PHASE(8) MK_PHASE(9)
    MK_PHASE(10) MK_PHASE(11) MK_PHASE(12) MK_PHASE(13) MK_PHASE(14) MK_PHASE(15) MK_PHASE(16) MK_PHASE(17) MK_PHASE(18) MK_PHASE(19)
#undef MK_PHASE
    xcd_barrier(xb);
}

extern "C" void kernel_launch(void* const* d_in, const int* in_sizes, int n_in, void* d_out, int out_size, void* d_ws, size_t ws_size, hipStream_t stream) {
    static int grid = 0;
    if (grid == 0) {
        int dev = 0, cus = 0, per_cu = 0;
        hipGetDevice(&dev);
        hipDeviceGetAttribute(&cus, hipDeviceAttributeMultiprocessorCount, dev);
        hipFuncSetAttribute((const void*)mk_fwd, hipFuncAttributeMaxDynamicSharedMemorySize, LDS_BYTES);
        hipOccupancyMaxActiveBlocksPerMultiprocessor(&per_cu, (const void*)mk_fwd, 512, LDS_BYTES);
        if (per_cu < 1) per_cu = 1;
        grid = cus * 1;
        if (n_in != 21 || ws_size < WS_END) fprintf(stderr, "kernel_launch: unexpected n_in %d or ws_size %zu (need %zu)\n", n_in, ws_size, (size_t)WS_END);
        (void)hipGetLastError();
    }
    Params P{};
    for (int i = 0; i < 21; ++i) P.in[i] = (const float*)d_in[i];
    P.out = (float*)d_out; P.ws = (unsigned char*)d_ws;
    (void)hipMemsetAsync((unsigned char*)d_ws + OFF_BAR, 0, 16384, stream);
#if MK_SINGLE
    int lo = 0, hi = N_PHASES;
    void* args[] = {&P, &lo, &hi};
    hipError_t e = hipLaunchCooperativeKernel((const void*)mk_fwd, dim3(grid), dim3(512), args, LDS_BYTES, stream);
    if (e != hipSuccess) fprintf(stderr, "cooperative launch failed: %s (grid %d)\n", hipGetErrorString(e), grid);
#else
    for (int ph = 0; ph < N_PHASES; ++ph) hipLaunchKernelGGL(mk_fwd, dim3(grid), dim3(512), LDS_BYTES, stream, P, ph, ph + 1);
#endif
}
```

```cpp
#include <hip/hip_runtime.h>
#include <hip/hip_cooperative_groups.h>
#include <cstdio>
namespace cg = cooperative_groups;
namespace pg8 {
#define PG8_LAS __attribute__((address_space(3)))
typedef unsigned short bf16_t;
typedef short bf16x8 __attribute__((ext_vector_type(8)));
typedef float f32x4 __attribute__((ext_vector_type(4)));
typedef unsigned u32x4 __attribute__((ext_vector_type(4)));
constexpr int BM = 256, BK = 64, HALF = 128, HTB = HALF * BK * 2  , STAGE_BYTES = 8 * HTB, NXCD = 8, WGM = 8;

__host__ __device__ __forceinline__ int lds_byte(int r, int c) { const int st = (r >> 4) * 2 + (c >> 5), rr = r & 15, cc = c & 31, ob = rr * 64 + cc * 2; return st * 1024 + (ob ^ (((ob >> 9) & 1) << 5)); }
__host__ __device__ __forceinline__ void stage_rc(int b, int& R, int& C) { const int st = b / 1024, sb = b % 1024, swz = sb ^ (((sb >> 9) & 1) << 5); R = (st >> 1) * 16 + swz / 64; C = (st & 1) * 32 + (swz % 64) / 2; }
__host__ __device__ __forceinline__ int perm32(int rho) { const int n = rho >> 4, i = rho & 15; return 8 * (i >> 2) + 4 * n + (i & 3); }

struct Unit { int pm, pn; };
struct Gemm { const bf16_t* A; const bf16_t* Bt; int M, N, K; };

struct StaticOrder {
    int nM, nN, nwg, G, c;
    __host__ __device__ void init(int M, int N, int G_, int c_) { nM = M / BM; nN = N / BM; nwg = nM * nN; G = G_; c = c_; }
    __host__ __device__ bool next(int i, Unit& u) const {
        const long L = (long)i * G + c; if (L >= nwg) return false;
        int wgid = (int)L; { const int q = nwg / NXCD, r = nwg % NXCD, xcd = wgid % NXCD, off = wgid / NXCD; wgid = (xcd < r ? xcd * (q + 1) : r * (q + 1) + (xcd - r) * q) + off; }
        const int nig = WGM * nN, gid = wgid / nig, fm = gid * WGM, gsz = (nM - fm) < WGM ? (nM - fm) : WGM;
        u.pm = fm + ((wgid % nig) % gsz); u.pn = (wgid % nig) / gsz; return true;
    }
    __device__ __forceinline__ void a_ready(const Unit&) const {}
    __device__ __forceinline__ void done(const Unit&) const {}
};
__device__ __forceinline__ unsigned cvt_pk_bf16(float lo, float hi) { unsigned r; asm volatile("v_cvt_pk_bf16_f32 %0, %1, %2" : "=v"(r) : "v"(lo), "v"(hi)); return r; }
typedef float f32x2 __attribute__((ext_vector_type(2)));
__device__ __forceinline__ f32x2 gelu_pk(f32x2 v) {
    const f32x2 av = __builtin_elementwise_abs(v), d = av * 0.2316418882f + 1.0f;
    f32x2 t; t.x = __builtin_amdgcn_rcpf(d.x); t.y = __builtin_amdgcn_rcpf(d.y);
    f32x2 q = t * 0.5307027145f + (-0.7265760135f); q = q * t + 0.7107068705f; q = q * t + (-0.142248368f); q = q * t + 0.127414796f; q = q * t;
    const f32x2 s = (v * v) * (-0.72134752044f);
    f32x2 e; e.x = __builtin_amdgcn_exp2f(s.x); e.y = __builtin_amdgcn_exp2f(s.y);
    const f32x2 m = v * (q * e), r = v - m;
    f32x2 o; o.x = v.x < 0.f ? m.x : r.x; o.y = v.y < 0.f ? m.y : r.y; return o;
}

struct EpiF32 {
    static constexpr bool PERM = false, AFTER_DRAIN = false;
    float* C; int ldc; const float* bias;
    __device__ __forceinline__ void operator()(const f32x4 (&acc)[2][2][4][2], const Unit& u, int wr, int wc, int fr, int fq) const {
        const int row0 = u.pm * BM + wr * 64 + fr, col0 = u.pn * BM + wc * 32 + 4 * fq;
        f32x4 bv[2][2];
#pragma unroll
        for (int bj = 0; bj < 2; ++bj)
#pragma unroll
            for (int n = 0; n < 2; ++n) bv[bj][n] = bias ? *(const f32x4*)(bias + col0 + bj * HALF + n * 16) : (f32x4){0.f, 0.f, 0.f, 0.f};
#pragma unroll
        for (int ai = 0; ai < 2; ++ai)
#pragma unroll
            for (int m = 0; m < 4; ++m) { float* rowp = C + (size_t)(row0 + ai * HALF + m * 16) * ldc + col0;
#pragma unroll
                for (int bj = 0; bj < 2; ++bj)
#pragma unroll
                    for (int n = 0; n < 2; ++n) *(f32x4*)(rowp + bj * HALF + n * 16) = acc[ai][bj][m][n] + bv[bj][n]; }
    }
};
template <int ACT  > struct EpiBf16 {
    static constexpr bool PERM = true, AFTER_DRAIN = false;
    bf16_t* O; int ldc; const float* bias; int split_cols; size_t split_stride;
    __device__ __forceinline__ void operator()(const f32x4 (&acc)[2][2][4][2], const Unit& u, int wr, int wc, int fr, int fq) const {
        const int row0 = u.pm * BM + wr * 64 + fr; int colt = u.pn * BM; bf16_t* base = O;
        if (split_cols) { const int t = colt / split_cols; base += (size_t)t * split_stride; colt -= t * split_cols; }
        const int col0 = colt + wc * 32 + 8 * fq, bcol0 = u.pn * BM + wc * 32 + 8 * fq;
        f32x4 bv[2][2];
#pragma unroll
        for (int bj = 0; bj < 2; ++bj)
#pragma unroll
            for (int n = 0; n < 2; ++n) bv[bj][n] = bias ? *(const f32x4*)(bias + bcol0 + bj * HALF + 4 * n) : (f32x4){0.f, 0.f, 0.f, 0.f};
#pragma unroll
        for (int ai = 0; ai < 2; ++ai)
#pragma unroll
            for (int m = 0; m < 4; ++m) { bf16_t* rowp = base + (size_t)(row0 + ai * HALF + m * 16) * ldc + col0;
#pragma unroll
                for (int bj = 0; bj < 2; ++bj) { f32x4 v0 = acc[ai][bj][m][0] + bv[bj][0], v1 = acc[ai][bj][m][1] + bv[bj][1];
                    if (ACT == 1) { f32x2 a = gelu_pk((f32x2){v0[0], v0[1]}), b = gelu_pk((f32x2){v0[2], v0[3]}), c = gelu_pk((f32x2){v1[0], v1[1]}), d = gelu_pk((f32x2){v1[2], v1[3]});
                        v0 = (f32x4){a.x, a.y, b.x, b.y}; v1 = (f32x4){c.x, c.y, d.x, d.y}; }
                    if (ACT == 2) {
#pragma unroll
                        for (int j = 0; j < 4; ++j) { v0[j] = 0.5f * v0[j] * (1.0f + erff(v0[j] * 0.70710678f)); v1[j] = 0.5f * v1[j] * (1.0f + erff(v1[j] * 0.70710678f)); } }
                    u32x4 w; w.x = cvt_pk_bf16(v0[0], v0[1]); w.y = cvt_pk_bf16(v0[2], v0[3]); w.z = cvt_pk_bf16(v1[0], v1[1]); w.w = cvt_pk_bf16(v1[2], v1[3]);
                    *(u32x4*)(rowp + bj * HALF) = w; } }
    }
};

template <class Epi, class Sched, bool ALIGN_EPI = false, bool SP2 = false>
__device__ __forceinline__ void gemm_phase(PG8_LAS unsigned char* lds, const Gemm g, const Sched& S, const Epi& E) {
    const int tid = threadIdx.x, wid = __builtin_amdgcn_readfirstlane(tid >> 6), lane = tid & 63, wr = wid >> 2, wc = wid & 3, fr = lane & 15, fq = lane >> 4;
    const int K = g.K, nt = K / BK;
    unsigned voffA[2], voffB[2];
#pragma unroll
    for (int i = 0; i < 2; ++i) { int R, C; stage_rc(tid * 16 + i * 8192, R, C); const int Rb = Epi::PERM ? ((R & ~31) + perm32(R & 31)) : R;
        voffA[i] = (unsigned)(R * K + C) * 2u; voffB[i] = (unsigned)(Rb * K + C) * 2u; }
    const size_t kstep = (size_t)(BK * 2);
    const size_t hstep = (size_t)HALF * K * 2;
    const size_t tstep = 2 * hstep;
    const unsigned ldsw = (unsigned)wid * 1024u;
    const int aoff = lds_byte(wr * 64 + fr, fq * 8), boff = lds_byte(wc * 32 + fr, fq * 8);
#define PG8_SA(b, h) (((b) * 2 + (h)) * HTB)
#define PG8_SB(b, h) ((4 + (b) * 2 + (h)) * HTB)
#define PG8_STAGE(bufoff, gbase, voff) do { _Pragma("unroll") for (int _i = 0; _i < 2; ++_i) \
        __builtin_amdgcn_global_load_lds((const unsigned*)((const char*)(gbase) + (voff)[_i]), (PG8_LAS unsigned*)(lds + (bufoff) + ldsw + _i * 8192), 16, 0, 0); } while (0)
#define PG8_LDA(dst, b, h) do { _Pragma("unroll") for (int m = 0; m < 4; ++m) _Pragma("unroll") for (int k = 0; k < 2; ++k) dst[m][k] = *(const PG8_LAS bf16x8*)(lds + PG8_SA(b, h) + aoff + m * 2048 + k * 1024); } while (0)
#define PG8_LDB(dst, b, h) do { _Pragma("unroll") for (int n = 0; n < 2; ++n) _Pragma("unroll") for (int k = 0; k < 2; ++k) dst[n][k] = *(const PG8_LAS bf16x8*)(lds + PG8_SB(b, h) + boff + n * 2048 + k * 1024); } while (0)
#define PG8_MMA(ai, bj, At, Bt) do { __builtin_amdgcn_s_setprio(1); _Pragma("unroll") for (int m = 0; m < 4; ++m) _Pragma("unroll") for (int n = 0; n < 2; ++n) _Pragma("unroll") for (int k = 0; k < 2; ++k) \
        acc[ai][bj][m][n] = __builtin_amdgcn_mfma_f32_16x16x32_bf16(Bt[n][k], At[m][k], acc[ai][bj][m][n], 0, 0, 0); __builtin_amdgcn_s_setprio(0); } while (0)
#define PG8_WAIT_V(n) asm volatile("s_waitcnt vmcnt(" #n ")" ::: "memory")
#define PG8_WAIT_L(n) asm volatile("s_waitcnt lgkmcnt(" #n ")" ::: "memory")
#define PG8_BAR __builtin_amdgcn_s_barrier()
#define PG8_SCHED __builtin_amdgcn_sched_barrier(0)
    Unit cur, nxt; int ui = 0;
    if (!S.next(0, cur)) return;
    f32x4 acc[2][2][4][2];
#pragma unroll
    for (int a = 0; a < 2; ++a)
#pragma unroll
        for (int b = 0; b < 2; ++b)
#pragma unroll
            for (int m = 0; m < 4; ++m)
#pragma unroll
                for (int n = 0; n < 2; ++n) acc[a][b][m][n] = (f32x4){0.f, 0.f, 0.f, 0.f};
    bf16x8 At[4][2], B0[2][2], B1[2][2];
    const char* cA = (const char*)g.A + (size_t)cur.pm * tstep; const char* cB = (const char*)g.Bt + (size_t)cur.pn * tstep;
    S.a_ready(cur);
    if constexpr (SP2) {
        PG8_STAGE(PG8_SB(0, 0), cB, voffB); PG8_STAGE(PG8_SB(0, 1), cB + hstep, voffB); PG8_STAGE(PG8_SA(0, 0), cA, voffA); PG8_STAGE(PG8_SA(0, 1), cA + hstep, voffA);
        if (wr == 1) PG8_BAR;
        PG8_WAIT_V(2); PG8_BAR;
        PG8_STAGE(PG8_SB(1, 0), cB + kstep, voffB); PG8_STAGE(PG8_SA(1, 0), cA + kstep, voffA); PG8_STAGE(PG8_SB(1, 1), cB + hstep + kstep, voffB);
        PG8_WAIT_V(6); PG8_BAR;
    } else {
        PG8_STAGE(PG8_SB(0, 0), cB, voffB); PG8_STAGE(PG8_SA(0, 0), cA, voffA); PG8_STAGE(PG8_SB(0, 1), cB + hstep, voffB); PG8_STAGE(PG8_SA(0, 1), cA + hstep, voffA);
        if (wr == 1) PG8_BAR;
        PG8_WAIT_V(4); PG8_BAR;
        PG8_STAGE(PG8_SB(1, 0), cB + kstep, voffB); PG8_STAGE(PG8_SA(1, 0), cA + kstep, voffA); PG8_STAGE(PG8_SB(1, 1), cB + hstep + kstep, voffB);
        PG8_WAIT_V(6); PG8_BAR;
    }
    for (;;) {
        const bool has_next = S.next(ui + 1, nxt);
        const char* nA = has_next ? (const char*)g.A + (size_t)nxt.pm * tstep : cA; const char* nB = has_next ? (const char*)g.Bt + (size_t)nxt.pn * tstep : cB;
        for (int t = 0; t < nt; t += 2) {
            const bool last = (t == nt - 2);
            const char* a1 = cA + (size_t)(t + 1) * kstep;
            const char* a2 = last ? nA : cA + (size_t)(t + 2) * kstep; const char* b2 = last ? nB : cB + (size_t)(t + 2) * kstep;
            const char* a3 = a2 + kstep; const char* b3 = b2 + kstep;
            if (last && has_next) S.a_ready(nxt);
            if constexpr (SP2) {
            PG8_LDB(B0, 0, 0); PG8_LDB(B1, 0, 1); PG8_SCHED; PG8_LDA(At, 0, 0); PG8_STAGE(PG8_SA(1, 1), a1 + hstep, voffA);
            PG8_WAIT_V(8); PG8_WAIT_L(0); PG8_BAR; PG8_MMA(0, 0, At, B0); PG8_MMA(0, 1, At, B1); PG8_BAR; PG8_SCHED;
            PG8_LDA(At, 0, 1); PG8_STAGE(PG8_SB(0, 0), b2, voffB); PG8_STAGE(PG8_SB(0, 1), b2 + hstep, voffB); PG8_STAGE(PG8_SA(0, 0), a2, voffA);
            PG8_WAIT_V(8); PG8_WAIT_L(0); PG8_BAR; PG8_MMA(1, 0, At, B0); PG8_MMA(1, 1, At, B1); PG8_BAR; PG8_SCHED;
            PG8_LDB(B0, 1, 0); PG8_LDB(B1, 1, 1); PG8_SCHED; PG8_LDA(At, 1, 0); PG8_STAGE(PG8_SA(0, 1), a2 + hstep, voffA);
            PG8_WAIT_V(8); PG8_WAIT_L(0); PG8_BAR; PG8_MMA(0, 0, At, B0); PG8_MMA(0, 1, At, B1); PG8_BAR; PG8_SCHED;
            PG8_LDA(At, 1, 1); PG8_STAGE(PG8_SB(1, 0), b3, voffB); PG8_STAGE(PG8_SB(1, 1), b3 + hstep, voffB); PG8_STAGE(PG8_SA(1, 0), a3, voffA);
            PG8_WAIT_V(8); PG8_WAIT_L(0); PG8_BAR; PG8_MMA(1, 0, At, B0); PG8_MMA(1, 1, At, B1); PG8_BAR; PG8_SCHED;
            } else {
            PG8_LDB(B0, 0, 0); PG8_SCHED; PG8_LDA(At, 0, 0); PG8_STAGE(PG8_SA(1, 1), a1 + hstep, voffA);
            PG8_WAIT_L(8); PG8_BAR; PG8_WAIT_L(0); PG8_MMA(0, 0, At, B0); PG8_BAR; PG8_SCHED;
            PG8_LDB(B1, 0, 1); PG8_STAGE(PG8_SB(0, 0), b2, voffB);
            PG8_BAR; PG8_WAIT_L(0); PG8_MMA(0, 1, At, B1); PG8_BAR;
            PG8_LDA(At, 0, 1); PG8_STAGE(PG8_SA(0, 0), a2, voffA);
            PG8_BAR; PG8_WAIT_L(0); PG8_MMA(1, 0, At, B0); PG8_BAR; PG8_SCHED;
            PG8_STAGE(PG8_SB(0, 1), b2 + hstep, voffB);
            PG8_WAIT_V(6); PG8_BAR; PG8_MMA(1, 1, At, B1); PG8_BAR;
            PG8_LDB(B0, 1, 0); PG8_SCHED; PG8_LDA(At, 1, 0); PG8_STAGE(PG8_SA(0, 1), a2 + hstep, voffA);
            PG8_WAIT_L(8); PG8_BAR; PG8_WAIT_L(0); PG8_MMA(0, 0, At, B0); PG8_BAR; PG8_SCHED;
            PG8_LDB(B1, 1, 1); PG8_STAGE(PG8_SB(1, 0), b3, voffB);
            PG8_BAR; PG8_WAIT_L(0); PG8_MMA(0, 1, At, B1); PG8_BAR;
            PG8_LDA(At, 1, 1); PG8_STAGE(PG8_SA(1, 0), a3, voffA);
            PG8_BAR; PG8_WAIT_L(0); PG8_MMA(1, 0, At, B0); PG8_BAR; PG8_SCHED;
            PG8_STAGE(PG8_SB(1, 1), b3 + hstep, voffB);
            PG8_WAIT_V(6); PG8_BAR; PG8_MMA(1, 1, At, B1); PG8_BAR;
            }
        }
        if constexpr (ALIGN_EPI) { if (wr == 0) PG8_BAR; }
        if constexpr (!Epi::AFTER_DRAIN) { E(acc, cur, wr, wc, fr, fq); S.done(cur); }
        if (!has_next) break;
#pragma unroll
        for (int a = 0; a < 2; ++a)
#pragma unroll
            for (int b = 0; b < 2; ++b)
#pragma unroll
                for (int m = 0; m < 4; ++m)
#pragma unroll
                    for (int n = 0; n < 2; ++n) acc[a][b][m][n] = (f32x4){0.f, 0.f, 0.f, 0.f};
        cur = nxt; cA = nA; cB = nB; ++ui;
        if constexpr (ALIGN_EPI) { if (wr == 1) PG8_BAR; }
    }
    PG8_WAIT_V(0);
    if constexpr (!ALIGN_EPI) { if (wr == 0) PG8_BAR; }
    PG8_BAR;
    if constexpr (Epi::AFTER_DRAIN) { E.fused(acc, cur, wr, wc, fr, fq, lds, wid, lane); S.done(cur); }
#undef PG8_SA
#undef PG8_SB
#undef PG8_STAGE
#undef PG8_LDA
#undef PG8_LDB
#undef PG8_MMA
#undef PG8_WAIT_V
#undef PG8_WAIT_L
#undef PG8_BAR
#undef PG8_SCHED
}
}

using pg8::bf16_t; using pg8::bf16x8; using pg8::f32x4; using pg8::u32x4;
typedef unsigned u32x2 __attribute__((ext_vector_type(2)));

#ifndef MK_SINGLE
#define MK_SINGLE 1
#endif

constexpr int DM = 1024, NLAT = 32768, NROWS = 33280, INC = 3584, DFF = 2816, NGU = 5632;
constexpr float EPSV = 1e-6f;
constexpr int LDS_BYTES = 131072;

constexpr size_t SZ_WIN = (size_t)INC * DM * 2, SZ_WOUT = (size_t)DM * DM * 2, SZ_WGU = (size_t)NGU * DM * 2, SZ_WDN = (size_t)DM * DFF * 2;
constexpr size_t OFF_WIN = 0;
constexpr size_t OFF_WOUT = OFF_WIN + 2 * SZ_WIN;
constexpr size_t OFF_WGU = OFF_WOUT + 2 * SZ_WOUT;
constexpr size_t OFF_WDN = OFF_WGU + 2 * SZ_WGU;
constexpr size_t OFF_MODS = OFF_WDN + 2 * SZ_WDN;
constexpr size_t OFF_LB = OFF_MODS + 2 * 3 * 6144 * 4;
constexpr size_t OFF_HGD = OFF_LB + 2 * 2 * 512 * 4;
constexpr size_t OFF_RGAGG = OFF_HGD + 16 * 64 * 128 * 4;
constexpr size_t OFF_XCTX = OFF_RGAGG + (size_t)2 * 2 * 260 * 2 * 512 * 4;
constexpr size_t OFF_WF = OFF_XCTX + (size_t)512 * 1024 * 4;
constexpr size_t OFF_BAR = OFF_WF + (size_t)32768 * 16;
constexpr size_t OFF_R1 = OFF_BAR + 16384;
constexpr size_t OFF_R2 = OFF_R1 + (size_t)NROWS * INC * 2;
constexpr size_t OFF_R3 = OFF_R2 + (size_t)NROWS * DM * 2;
constexpr size_t OFF_R4 = OFF_R3 + (size_t)NROWS * DM * 2;
constexpr size_t WS_END = OFF_R4 + (size_t)NROWS * DM * 2;

struct Params { const float* in[21]; float* out; unsigned char* ws; };

__device__ __forceinline__ float bf2f(bf16_t b) { return __uint_as_float(((unsigned)b) << 16); }
__device__ __forceinline__ bf16_t f2bf(float f) { unsigned u = __float_as_uint(f); u += 0x7FFFu + ((u >> 16) & 1u); return (bf16_t)(u >> 16); }
__device__ __forceinline__ float sigmoidf_(float x) { return __builtin_amdgcn_rcpf(1.0f + __expf(-x)); }
__device__ __forceinline__ float wave_sum(float v) {
    v += __int_as_float(__builtin_amdgcn_update_dpp(0, __float_as_int(v), 0xB1, 0xF, 0xF, true)); v += __int_as_float(__builtin_amdgcn_update_dpp(0, __float_as_int(v), 0x4E, 0xF, 0xF, true));
    v += __int_as_float(__builtin_amdgcn_update_dpp(0, __float_as_int(v), 0x141, 0xF, 0xF, true)); v += __int_as_float(__builtin_amdgcn_update_dpp(0, __float_as_int(v), 0x140, 0xF, 0xF, true));
    const float r0 = __int_as_float(__builtin_amdgcn_readlane(__float_as_int(v), 0)), r1 = __int_as_float(__builtin_amdgcn_readlane(__float_as_int(v), 16));
    const float r2 = __int_as_float(__builtin_amdgcn_readlane(__float_as_int(v), 32)), r3 = __int_as_float(__builtin_amdgcn_readlane(__float_as_int(v), 48));
    return (r0 + r1) + (r2 + r3);
}

struct EpiSwiglu {
    static constexpr bool PERM = false, AFTER_DRAIN = false;
    bf16_t* O; int ldc;
    __device__ __forceinline__ void operator()(const f32x4 (&acc)[2][2][4][2], const pg8::Unit& u, int wr, int wc, int fr, int fq) const {
        const int row0 = u.pm * 256 + wr * 64 + fr, col0 = u.pn * 128 + wc * 16 + 4 * fq;
#pragma unroll
        for (int ai = 0; ai < 2; ++ai)
#pragma unroll
            for (int m = 0; m < 4; ++m) { bf16_t* rowp = O + (size_t)(row0 + ai * 128 + m * 16) * ldc + col0;
#pragma unroll
                for (int bj = 0; bj < 2; ++bj) { const f32x4 g = acc[ai][bj][m][0], uu = acc[ai][bj][m][1];
                    typedef float f32x2 __attribute__((ext_vector_type(2)));
                    const f32x2 one2 = (f32x2){1.0f, 1.0f}, nl2e = (f32x2){-1.4426950408889634f, -1.4426950408889634f};
                    const f32x2 g0 = (f32x2){g[0], g[1]}, g1 = (f32x2){g[2], g[3]}, u0 = (f32x2){uu[0], uu[1]}, u1 = (f32x2){uu[2], uu[3]};
                    const f32x2 n0 = g0 * nl2e, n1 = g1 * nl2e;
                    const f32x2 t0 = (f32x2){__builtin_amdgcn_exp2f(n0.x), __builtin_amdgcn_exp2f(n0.y)} + one2, t1 = (f32x2){__builtin_amdgcn_exp2f(n1.x), __builtin_amdgcn_exp2f(n1.y)} + one2;
                    const f32x2 h0 = g0 * u0 * (f32x2){__builtin_amdgcn_rcpf(t0.x), __builtin_amdgcn_rcpf(t0.y)}, h1 = g1 * u1 * (f32x2){__builtin_amdgcn_rcpf(t1.x), __builtin_amdgcn_rcpf(t1.y)};
                    u32x2 w; w.x = pg8::cvt_pk_bf16(h0.x, h0.y); w.y = pg8::cvt_pk_bf16(h1.x, h1.y);
                    *(u32x2*)(rowp + bj * 64) = w; } }
    }
};

__device__ __forceinline__ void conv_tile(const float* __restrict__ src, int ldS, bf16_t* __restrict__ dst, int ldD, int kt, int nt, int mode, float* tile) {
    const int tid = threadIdx.x;
    { const int r = tid >> 4, c4 = (tid & 15) * 4;
#pragma unroll
      for (int it = 0; it < 2; ++it) { const int row = it * 32 + r; const float4 v = *(const float4*)(src + (size_t)(64 * kt + row) * ldS + 64 * nt + c4);
          float* tp = tile + row * 65 + c4; tp[0] = v.x; tp[1] = v.y; tp[2] = v.z; tp[3] = v.w; } }
    __syncthreads();
    { const int n = tid >> 3, k8 = (tid & 7) * 8; const int N = 64 * nt + n;
      const int drow = mode == 0 ? N : (32 * (N >> 4) + (N & 15) + (mode == 2 ? 16 : 0));
      float v[8];
#pragma unroll
      for (int j = 0; j < 8; ++j) v[j] = tile[(k8 + j) * 65 + n];
      u32x4 w; w.x = pg8::cvt_pk_bf16(v[0], v[1]); w.y = pg8::cvt_pk_bf16(v[2], v[3]); w.z = pg8::cvt_pk_bf16(v[4], v[5]); w.w = pg8::cvt_pk_bf16(v[6], v[7]);
      *(u32x4*)(dst + (size_t)drow * ldD + 64 * kt + k8) = w; }
    __syncthreads();
}

__device__ __forceinline__ void phase_prep(const Params& P, unsigned char* shm) {
    const int tid = threadIdx.x, G = gridDim.x, bid = blockIdx.x;
    float* tile = (float*)shm;
    float* sv = (float*)(shm + 16640);
    float* red = (float*)(shm + 16640 + 12288);
    for (int e = tid; e < 3072; e += 512) { const int v = e >> 10, d = e & 1023; const float x = v < 2 ? P.in[1][v * 1024 + d] : P.in[3][d]; sv[e] = x * sigmoidf_(x); }
    { const int gi = bid * 512 + tid; if (gi < 2048) { float* lb = (float*)(P.ws + OFF_LB); const int l = gi >> 10, r = gi & 1023;
        float val = 0.f; if (l == 1) { const float l0 = P.in[8][r], l1 = P.in[8][1024 + r]; val = 1.0f / (1.0f + expf(l0 - l1)); } lb[gi] = val; } }
    for (int gi = bid * 512 + tid; gi < 32768; gi += G * 512) {
        const int ln = gi & 63, kk = (gi >> 6) & 1, nt = (gi >> 7) & 3, mat = (gi >> 9) & 1, ldn = gi >> 10;
        const float* src = (mat ? P.in[14] : P.in[12]) + (size_t)ldn * 4096 + (32 * kk + 8 * (ln >> 4)) * 64 + 16 * nt + (ln & 15);
        float v[8];
#pragma unroll
        for (int jj = 0; jj < 8; ++jj) v[jj] = src[jj * 64] * -1.4426950408889634f;
        u32x4 wv; wv.x = pg8::cvt_pk_bf16(v[0], v[1]); wv.y = pg8::cvt_pk_bf16(v[2], v[3]); wv.z = pg8::cvt_pk_bf16(v[4], v[5]); wv.w = pg8::cvt_pk_bf16(v[6], v[7]);
        ((u32x4*)(P.ws + OFF_WF))[gi] = wv;
    }
    __syncthreads();
    for (int it = bid; it < 192; it += G) {
        const int l = it / 96, n0 = (it % 96) * 64, w = tid >> 6, lane = tid & 63;
        const float* wm = P.in[4] + (size_t)l * 1024 * 6144 + n0 + lane;
        float a0 = 0.f, a1 = 0.f, a2 = 0.f;
#pragma unroll 32
        for (int dd = 0; dd < 128; ++dd) { const int d = w * 128 + dd; const float wv = wm[(size_t)d * 6144]; a0 += sv[d] * wv; a1 += sv[1024 + d] * wv; a2 += sv[2048 + d] * wv; }
        red[(w * 3 + 0) * 64 + lane] = a0; red[(w * 3 + 1) * 64 + lane] = a1; red[(w * 3 + 2) * 64 + lane] = a2;
        __syncthreads();
        if (tid < 192) { const int v = tid >> 6, ln = tid & 63; float s = P.in[5][l * 6144 + n0 + ln];
#pragma unroll
            for (int ww = 0; ww < 8; ++ww) s += red[(ww * 3 + v) * 64 + ln];
            ((float*)(P.ws + OFF_MODS))[(size_t)(l * 3 + v) * 6144 + n0 + ln] = s; }
        __syncthreads();
    }
    {
        const float* src = nullptr; bf16_t* dst = nullptr; int ldS = 0, ldD = 0, kt = 0, nt = 0, mode = 0;
#define WC_DECODE(TI) do { const int l_ = (TI) / 3264; int r_ = (TI) % 3264; int ntn_; \
        if (r_ < 896) { src = P.in[7] + (size_t)l_ * DM * INC; ldS = INC; dst = (bf16_t*)(P.ws + OFF_WIN + l_ * SZ_WIN); ldD = DM; ntn_ = 56; mode = 0; } \
        else if (r_ < 1152) { r_ -= 896; src = P.in[17] + (size_t)l_ * DM * DM; ldS = DM; dst = (bf16_t*)(P.ws + OFF_WOUT + l_ * SZ_WOUT); ldD = DM; ntn_ = 16; mode = 0; } \
        else if (r_ < 1856) { r_ -= 1152; src = P.in[18] + (size_t)l_ * DM * DFF; ldS = DFF; dst = (bf16_t*)(P.ws + OFF_WGU + l_ * SZ_WGU); ldD = DM; ntn_ = 44; mode = 1; } \
        else if (r_ < 2560) { r_ -= 1856; src = P.in[19] + (size_t)l_ * DM * DFF; ldS = DFF; dst = (bf16_t*)(P.ws + OFF_WGU + l_ * SZ_WGU); ldD = DM; ntn_ = 44; mode = 2; } \
        else { r_ -= 2560; src = P.in[20] + (size_t)l_ * DFF * DM; ldS = DM; dst = (bf16_t*)(P.ws + OFF_WDN + l_ * SZ_WDN); ldD = DFF; ntn_ = 16; mode = 0; } \
        kt = r_ / ntn_; nt = r_ % ntn_; } while (0)
#define WC_BAR() asm volatile("s_waitcnt lgkmcnt(0)\n\ts_barrier" ::: "memory")
        const int lr = tid >> 4, lc4 = (tid & 15) * 4;
        float4 pv0 = make_float4(0.f, 0.f, 0.f, 0.f), pv1 = pv0;
        int ti = bid;
        if (ti < 6528) { WC_DECODE(ti); pv0 = *(const float4*)(src + (size_t)(64 * kt + lr) * ldS + 64 * nt + lc4); pv1 = *(const float4*)(src + (size_t)(64 * kt + 32 + lr) * ldS + 64 * nt + lc4); }
        for (; ti < 6528; ti += G) {
            { float* tp = tile + lr * 65 + lc4; tp[0] = pv0.x; tp[1] = pv0.y; tp[2] = pv0.z; tp[3] = pv0.w; tp += 32 * 65; tp[0] = pv1.x; tp[1] = pv1.y; tp[2] = pv1.z; tp[3] = pv1.w; }
            bf16_t* cdst = dst; const int cldD = ldD, ckt = kt, cnt = nt, cmode = mode;
            if (ti + G < 6528) { WC_DECODE(ti + G); pv0 = *(const float4*)(src + (size_t)(64 * kt + lr) * ldS + 64 * nt + lc4); pv1 = *(const float4*)(src + (size_t)(64 * kt + 32 + lr) * ldS + 64 * nt + lc4); }
            WC_BAR();
            { const int n = tid >> 3, k8 = (tid & 7) * 8; const int N = 64 * cnt + n;
              const int drow = cmode == 0 ? N : (32 * (N >> 4) + (N & 15) + (cmode == 2 ? 16 : 0));
              float v[8];
#pragma unroll
              for (int jx = 0; jx < 8; ++jx) v[jx] = tile[(k8 + jx) * 65 + n];
              u32x4 wv; wv.x = pg8::cvt_pk_bf16(v[0], v[1]); wv.y = pg8::cvt_pk_bf16(v[2], v[3]); wv.z = pg8::cvt_pk_bf16(v[4], v[5]); wv.w = pg8::cvt_pk_bf16(v[6], v[7]);
              *(u32x4*)(cdst + (size_t)drow * cldD + 64 * ckt + k8) = wv; }
            WC_BAR();
        }
#undef WC_DECODE
#undef WC_BAR
        __syncthreads();
    }
}

struct RowOp {
    const float* xs_lat; const float* xs_ctx; float* xd_lat; float* xd_ctx;
    const bf16_t* xs_lat_b; bf16_t* xd_lat_b;
    const bf16_t* y; const float* yw; const float* mods_y; int gate_idx;
    bf16_t* hdst; const float* hw; const float* mods_h; int shift_idx, scale_idx;
    int nrows;
};
template <bool SRC_B, bool DST_B>
__device__ __forceinline__ void phase_rowop(const RowOp& R, unsigned char* shm) {
    const int w = threadIdx.x >> 6, lane = threadIdx.x & 63;
    PG8_LAS float* md = (PG8_LAS float*)shm;
    for (int e = threadIdx.x; e < 3 * 3 * 1024; e += 512) { const int v = e / 3072, k = (e / 1024) % 3, cidx = e & 1023;
        float val = 0.f;
        if (k == 0) { if (R.y) val = R.mods_y[(size_t)(v * 6 + R.gate_idx) * 1024 + cidx]; }
        else if (R.hdst) val = R.mods_h[(size_t)(v * 6 + (k == 1 ? R.shift_idx : R.scale_idx)) * 1024 + cidx];
        md[e] = val; }
    float4 ywv[4], hwv[4];
#pragma unroll
    for (int j = 0; j < 4; ++j) { ywv[j] = R.y ? *(const float4*)(R.yw + j * 256 + lane * 4) : make_float4(0.f, 0.f, 0.f, 0.f); hwv[j] = R.hdst ? *(const float4*)(R.hw + j * 256 + lane * 4) : make_float4(0.f, 0.f, 0.f, 0.f); }
    __syncthreads();
    float4 nx[2][4]; u32x2 ny[2][4];
#define ROW_LOAD(SLOT, ROW) do { const int r_ = (ROW); \
        if (SRC_B && r_ < NLAT) { const bf16_t* xb_ = R.xs_lat_b + (size_t)r_ * DM; \
            _Pragma("unroll") for (int j = 0; j < 4; ++j) { const u32x2 t_ = *(const u32x2*)(xb_ + j * 256 + lane * 4); nx[SLOT][j].x = __uint_as_float(t_.x); nx[SLOT][j].y = __uint_as_float(t_.y); } } \
        else { const float* xs_ = r_ >= NLAT ? R.xs_ctx + (size_t)(r_ - NLAT) * DM : R.xs_lat + (size_t)r_ * DM; \
        _Pragma("unroll") for (int j = 0; j < 4; ++j) nx[SLOT][j] = *(const float4*)(xs_ + j * 256 + lane * 4); } \
        if (R.y) { _Pragma("unroll") for (int j = 0; j < 4; ++j) ny[SLOT][j] = *(const u32x2*)(R.y + (size_t)r_ * DM + j * 256 + lane * 4); } } while (0)
    const int row0 = blockIdx.x * 8 + w, rstride = gridDim.x * 8;
    if (row0 < R.nrows) ROW_LOAD(0, row0);
    if (row0 + rstride < R.nrows) ROW_LOAD(1, row0 + rstride);
#pragma unroll 1
    for (int rowb = row0; rowb < R.nrows; rowb += 2 * rstride) {
#pragma unroll
      for (int u = 0; u < 2; ++u) {
        const int row = rowb + u * rstride;
        if (row < R.nrows) {
        const bool isctx = row >= NLAT; const int v = isctx ? 2 : (row >> 14);
        float xv[16]; u32x2 cy[4];
        if (SRC_B && !isctx) {
#pragma unroll
            for (int j = 0; j < 4; ++j) { const unsigned a_ = __float_as_uint(nx[u][j].x), b_ = __float_as_uint(nx[u][j].y);
                xv[4 * j] = __uint_as_float(a_ << 16); xv[4 * j + 1] = __uint_as_float(a_ & 0xffff0000u); xv[4 * j + 2] = __uint_as_float(b_ << 16); xv[4 * j + 3] = __uint_as_float(b_ & 0xffff0000u); cy[j] = ny[u][j]; }
        } else {
#pragma unroll
            for (int j = 0; j < 4; ++j) { xv[4 * j] = nx[u][j].x; xv[4 * j + 1] = nx[u][j].y; xv[4 * j + 2] = nx[u][j].z; xv[4 * j + 3] = nx[u][j].w; cy[j] = ny[u][j]; }
        }
        if (row + 2 * rstride < R.nrows) ROW_LOAD(u, row + 2 * rstride);
        const PG8_LAS float* mdv = md + v * 3072;
        if (R.y) {
            float yv[16]; float ss = 0.f;
#pragma unroll
            for (int j = 0; j < 4; ++j) { const u32x2 t = cy[j];
                yv[4 * j] = __uint_as_float(t.x << 16); yv[4 * j + 1] = __uint_as_float(t.x & 0xffff0000u); yv[4 * j + 2] = __uint_as_float(t.y << 16); yv[4 * j + 3] = __uint_as_float(t.y & 0xffff0000u); }
#pragma unroll
            for (int e = 0; e < 16; ++e) ss += yv[e] * yv[e];
            ss = wave_sum(ss); const float rs = rsqrtf(ss * (1.0f / 1024.0f) + EPSV);
            float* xd = isctx ? R.xd_ctx + (size_t)(row - NLAT) * DM : R.xd_lat + (size_t)row * DM;
#pragma unroll
            for (int j = 0; j < 4; ++j) { const int c0 = j * 256 + lane * 4; const f32x4 gt = *(const PG8_LAS f32x4*)(mdv + c0); const float4 wt = ywv[j];
                xv[4 * j] += gt[0] * (yv[4 * j] * rs * wt.x); xv[4 * j + 1] += gt[1] * (yv[4 * j + 1] * rs * wt.y); xv[4 * j + 2] += gt[2] * (yv[4 * j + 2] * rs * wt.z); xv[4 * j + 3] += gt[3] * (yv[4 * j + 3] * rs * wt.w);
                if (DST_B && !isctx) { u32x2 ob; ob.x = pg8::cvt_pk_bf16(xv[4 * j], xv[4 * j + 1]); ob.y = pg8::cvt_pk_bf16(xv[4 * j + 2], xv[4 * j + 3]); *(u32x2*)(R.xd_lat_b + (size_t)row * DM + c0) = ob;
                    xv[4 * j] = __uint_as_float(ob.x << 16); xv[4 * j + 1] = __uint_as_float(ob.x & 0xffff0000u); xv[4 * j + 2] = __uint_as_float(ob.y << 16); xv[4 * j + 3] = __uint_as_float(ob.y & 0xffff0000u);
                }
                else { float4 o; o.x = xv[4 * j]; o.y = xv[4 * j + 1]; o.z = xv[4 * j + 2]; o.w = xv[4 * j + 3]; *(float4*)(xd + c0) = o; } }
        }
        if (R.hdst) {
            float ss = 0.f;
#pragma unroll
            for (int e = 0; e < 16; ++e) ss += xv[e] * xv[e];
            ss = wave_sum(ss); const float rs = rsqrtf(ss * (1.0f / 1024.0f) + EPSV);
#pragma unroll
            for (int j = 0; j < 4; ++j) { const int c0 = j * 256 + lane * 4; const f32x4 sh = *(const PG8_LAS f32x4*)(mdv + 1024 + c0); const f32x4 sc = *(const PG8_LAS f32x4*)(mdv + 2048 + c0); const float4 wt = hwv[j];
                const float h0 = xv[4 * j] * rs * wt.x * (1.0f + sc[0]) + sh[0], h1 = xv[4 * j + 1] * rs * wt.y * (1.0f + sc[1]) + sh[1];
                const float h2 = xv[4 * j + 2] * rs * wt.z * (1.0f + sc[2]) + sh[2], h3 = xv[4 * j + 3] * rs * wt.w * (1.0f + sc[3]) + sh[3];
                u32x2 o; o.x = pg8::cvt_pk_bf16(h0, h1); o.y = pg8::cvt_pk_bf16(h2, h3); *(u32x2*)(R.hdst + (size_t)row * DM + c0) = o; }
        }
        }
      }
    }
    __syncthreads();
#undef ROW_LOAD
}

constexpr int HG_QT = 0, HG_QH = 8192, HG_KH = 16384, HG_V = 24576, HG_SIMG = 32768, HG_AIMG = 65536, HG_OBUF = 68096, HG_WTOT = 84992, HG_ETOT = 89088;
constexpr int AI_LD = 40, OB_LD = 132;
typedef short s16x4 __attribute__((ext_vector_type(4)));
#define LBAR() asm volatile("s_waitcnt lgkmcnt(0)\n\ts_barrier" ::: "memory")

__device__ __forceinline__ unsigned off_b(unsigned row, unsigned ch) { return 256u * row + 16u * (ch ^ (((row & 3u) << 2) | ((row >> 2) & 3u))); }
__device__ __forceinline__ unsigned rr16(unsigned lane, unsigned rb, unsigned s) { return off_b((lane & 15u) + 16u * rb, 4u * s + (lane >> 4)); }
__device__ __forceinline__ unsigned tr16(unsigned lane, unsigned c, unsigned ks, unsigned t) { const unsigned g = lane >> 4, q = (lane & 15u) >> 2, p = lane & 3u; return off_b(32u * ks + 8u * g + 4u * t + q, 2u * c + (p >> 1)) + 8u * (p & 1u); }
__device__ __forceinline__ bf16x8 trfrag(PG8_LAS unsigned char* img, unsigned lane, unsigned c, unsigned ks) {
    const s16x4 a = __builtin_amdgcn_ds_read_tr16_b64_v4i16((PG8_LAS s16x4*)(img + tr16(lane, c, ks, 0)));
    const s16x4 b = __builtin_amdgcn_ds_read_tr16_b64_v4i16((PG8_LAS s16x4*)(img + tr16(lane, c, ks, 1)));
    bf16x8 r; r[0] = a[0]; r[1] = a[1]; r[2] = a[2]; r[3] = a[3]; r[4] = b[0]; r[5] = b[1]; r[6] = b[2]; r[7] = b[3]; return r;
}
__device__ __forceinline__ void unpack8(const u32x4 v, float* f) {
    f[0] = __uint_as_float(v.x << 16); f[1] = __uint_as_float(v.x & 0xffff0000u); f[2] = __uint_as_float(v.y << 16); f[3] = __uint_as_float(v.y & 0xffff0000u);
    f[4] = __uint_as_float(v.z << 16); f[5] = __uint_as_float(v.z & 0xffff0000u); f[6] = __uint_as_float(v.w << 16); f[7] = __uint_as_float(v.w & 0xffff0000u);
}
__device__ __forceinline__ u32x4 pack8(const float* f) { u32x4 w; w.x = pg8::cvt_pk_bf16(f[0], f[1]); w.y = pg8::cvt_pk_bf16(f[2], f[3]); w.z = pg8::cvt_pk_bf16(f[4], f[5]); w.w = pg8::cvt_pk_bf16(f[6], f[7]); return w; }

__device__ __forceinline__ int hg_row(int b, int d, int j, int s_in) {
    if (j == 0) { const int tc = d ? 255 - s_in : s_in; return NLAT + b * 256 + tc; }
    const int sl = (j - 1) * 256 + s_in; const int tl = d ? 16383 - sl : sl; return b * 16384 + tl;
}

#define HG_DPP8(CTRL) asm volatile( \
    "v_mul_f32_dpp %0, %0, %0 " CTRL "\n\tv_mul_f32_dpp %1, %1, %1 " CTRL "\n\tv_mul_f32_dpp %2, %2, %2 " CTRL "\n\tv_mul_f32_dpp %3, %3, %3 " CTRL "\n\t" \
    "v_mul_f32_dpp %4, %4, %4 " CTRL "\n\tv_mul_f32_dpp %5, %5, %5 " CTRL "\n\tv_mul_f32_dpp %6, %6, %6 " CTRL "\n\tv_mul_f32_dpp %7, %7, %7 " CTRL \
    : "+v"(x0), "+v"(x1), "+v"(x2), "+v"(x3), "+v"(x4), "+v"(x5), "+v"(x6), "+v"(x7))
__device__ __forceinline__ void scan32_prod8(float& x0, float& x1, float& x2, float& x3, float& x4, float& x5, float& x6, float& x7) {
    asm volatile("s_nop 1" ::: );
    HG_DPP8("row_shr:1 row_mask:0xf bank_mask:0xf"); HG_DPP8("row_shr:2 row_mask:0xf bank_mask:0xf"); HG_DPP8("row_shr:4 row_mask:0xf bank_mask:0xf"); HG_DPP8("row_shr:8 row_mask:0xf bank_mask:0xf");
    HG_DPP8("row_bcast:15 row_mask:0xa bank_mask:0xf");
}
template <int MODE>
__device__ __forceinline__ void hg_run(const Params& P, int layer, int b, int h, int d, int j, bool combine, unsigned char* shm) {
    typedef float f32x2 __attribute__((ext_vector_type(2)));
    const int tid = threadIdx.x, w = tid >> 6, lane = tid & 63, c = lane & 15, q = lane >> 4;
    const int t1 = tid >> 4, cg = tid & 15;
    const int ts = lane & 31, hb = lane >> 5, cgs = 2 * w + hb;
    PG8_LAS unsigned char* L = (PG8_LAS unsigned char*)shm;
    PG8_LAS bf16_t* Aimg = (PG8_LAS bf16_t*)(L + HG_AIMG); PG8_LAS float* Obuf = (PG8_LAS float*)(L + HG_OBUF); PG8_LAS float* etot = (PG8_LAS float*)(L + HG_ETOT);
    const bf16_t* p = (const bf16_t*)(P.ws + OFF_R1);
    bf16_t* mix = (bf16_t*)(P.ws + OFF_R3);
    float* states = (float*)(P.ws + OFF_R2);
    const int seq = (b * 4 + h) * 2 + d;
    f32x2 lb2[4];
    { const float* lbp = (const float*)(P.ws + OFF_LB) + (layer * 2 + d) * 512 + h * 128 + 8 * cgs;
      const float4 l0 = *(const float4*)lbp, l1 = *(const float4*)(lbp + 4);
      lb2[0] = (f32x2){l0.x, l0.y}; lb2[1] = (f32x2){l0.z, l0.w}; lb2[2] = (f32x2){l1.x, l1.y}; lb2[3] = (f32x2){l1.z, l1.w}; }
    f32x4 Sacc[8];
    if (MODE == 3 && j > 0) {
        const float* st = states + ((size_t)seq * 64 + (j - 1)) * 16384;
#pragma unroll
        for (int n = 0; n < 8; ++n) Sacc[n] = *(const f32x4*)(st + (16 * n + c) * 128 + 16 * w + 4 * q);
    } else {
#pragma unroll
        for (int n = 0; n < 8; ++n) Sacc[n] = (f32x4){0.f, 0.f, 0.f, 0.f};
    }
    if (MODE == 3) {
#pragma unroll
        for (int n = 0; n < 8; ++n) { u32x2 wv; wv.x = pg8::cvt_pk_bf16(Sacc[n][0], Sacc[n][1]); wv.y = pg8::cvt_pk_bf16(Sacc[n][2], Sacc[n][3]);
            *(PG8_LAS u32x2*)(L + HG_SIMG + off_b(16 * n + c, 2 * w + (q >> 1)) + 8 * (q & 1)) = wv; }
        if (tid < 256) Aimg[(tid >> 4) * AI_LD + 16 + (tid & 15)] = 0;
    }
    f32x2 sup2[4];
#pragma unroll
    for (int e2 = 0; e2 < 4; ++e2) sup2[e2] = (f32x2){1.0f, 1.0f};
    f32x4 gn0 = (f32x4){0.f, 0.f, 0.f, 0.f}, gn1 = gn0;
    if (MODE == 3 && combine) { const float* gnp = P.in[9] + layer * 128 + 8 * cg; gn0 = *(const f32x4*)gnp; gn1 = *(const f32x4*)(gnp + 4); }
    const f32x2 one2 = (f32x2){1.0f, 1.0f}, nl2e = (f32x2){-1.4426950408889634f, -1.4426950408889634f}, tiny2 = (f32x2){1e-30f, 1e-30f};
    const int colq = h * 128 + 8 * cgs, colz = 512 * (1 + d) + h * 128 + 8 * cgs, colv = 1536 + h * 128 + 8 * cgs;
    u32x4 nq = (u32x4){0u, 0u, 0u, 0u}, nz, nv, ng = (u32x4){0u, 0u, 0u, 0u}, nm = (u32x4){0u, 0u, 0u, 0u}; int nrow = 0;
#define HG_LOAD(CH) do { { const bf16_t* pr = p + (size_t)hg_row(b, d, j, (CH) * 32 + ts) * INC; if (MODE == 3) nq = *(const u32x4*)(pr + colq); nz = *(const u32x4*)(pr + colz); nv = *(const u32x4*)(pr + colv); } \
        if (MODE == 3) { nrow = hg_row(b, d, j, (CH) * 32 + t1); if (combine) { ng = *(const u32x4*)(p + (size_t)nrow * INC + 2048 + h * 128 + 8 * cg); nm = *(const u32x4*)(mix + (size_t)nrow * DM + h * 128 + 8 * cg); } } } while (0)
    HG_LOAD(0);
#pragma unroll 1
    for (int ch = 0; ch < 8; ++ch) {
        const u32x4 cq = nq, cz = nz, cv = nv, cgate = ng, cmix = nm; const int row = nrow;
        if (ch < 7) HG_LOAD(ch + 1);
        {
            f32x2 g2[4], kk2[4], qs2[4];
            { float zf[8]; unpack8(cz, zf);
#pragma unroll
              for (int e2 = 0; e2 < 4; ++e2) { const f32x2 nzz = (f32x2){zf[2 * e2], zf[2 * e2 + 1]} * nl2e;
                  const f32x2 t = (f32x2){__builtin_amdgcn_exp2f(nzz.x), __builtin_amdgcn_exp2f(nzz.y)} + one2;
                  const f32x2 inv = (f32x2){__builtin_amdgcn_rcpf(t.x), __builtin_amdgcn_rcpf(t.y)};
                  const f32x2 oml = one2 - lb2[e2];
                  g2[e2] = lb2[e2] + oml * inv;
                  kk2[e2] = oml - oml * inv; } }
            if (MODE == 3) { float qf[8]; unpack8(cq, qf);
#pragma unroll
                for (int e2 = 0; e2 < 4; ++e2) { const f32x2 qv = (f32x2){qf[2 * e2], qf[2 * e2 + 1]}; const f32x2 nqq = qv * nl2e;
                    const f32x2 t = (f32x2){__builtin_amdgcn_exp2f(nqq.x), __builtin_amdgcn_exp2f(nqq.y)} + one2;
                    qs2[e2] = qv * (f32x2){__builtin_amdgcn_rcpf(t.x), __builtin_amdgcn_rcpf(t.y)}; } }
            { float s0 = g2[0].x, s1 = g2[0].y, s2 = g2[1].x, s3 = g2[1].y, s4 = g2[2].x, s5 = g2[2].y, s6 = g2[3].x, s7 = g2[3].y;
              scan32_prod8(s0, s1, s2, s3, s4, s5, s6, s7);
              g2[0] = (f32x2){s0, s1}; g2[1] = (f32x2){s2, s3}; g2[2] = (f32x2){s4, s5}; g2[3] = (f32x2){s6, s7}; }
            float qt[8], qh[8];
#pragma unroll
            for (int e2 = 0; e2 < 4; ++e2) {
                const f32x2 cm = __builtin_elementwise_max(g2[e2], tiny2);
                const f32x2 kt2 = kk2[e2] * (f32x2){__builtin_amdgcn_rcpf(cm.x), __builtin_amdgcn_rcpf(cm.y)};
                qh[2 * e2] = kt2.x; qh[2 * e2 + 1] = kt2.y;
                if (MODE == 3) { const f32x2 qt2 = qs2[e2] * g2[e2]; qt[2 * e2] = qt2.x; qt[2 * e2 + 1] = qt2.y; }
                if (MODE == 1) sup2[e2] *= g2[e2]; }
            if (MODE == 1) LBAR();
            const unsigned ob = off_b(ts, cgs);
            *(PG8_LAS u32x4*)(L + HG_QH + ob) = pack8(qh);
            *(PG8_LAS u32x4*)(L + HG_V + ob) = cv;
            if (MODE == 3) *(PG8_LAS u32x4*)(L + HG_QT + ob) = pack8(qt);
            if (ts == 31) { *(PG8_LAS f32x4*)(etot + 8 * cgs) = (f32x4){g2[0].x, g2[0].y, g2[1].x, g2[1].y}; *(PG8_LAS f32x4*)(etot + 8 * cgs + 4) = (f32x4){g2[2].x, g2[2].y, g2[3].x, g2[3].y}; }
        }
        LBAR();
        if (MODE == 3) {
            if (w < 3) {
                const int mt = w ? 1 : 0, ms = w == 2 ? 1 : 0;
                f32x4 sc = (f32x4){0.f, 0.f, 0.f, 0.f};
#pragma unroll
                for (int k4 = 0; k4 < 4; ++k4) { const bf16x8 a = *(const PG8_LAS bf16x8*)(L + HG_QT + rr16(lane, mt, k4)); const bf16x8 bb = *(const PG8_LAS bf16x8*)(L + HG_QH + rr16(lane, ms, k4));
                    sc = __builtin_amdgcn_mfma_f32_16x16x32_bf16(a, bb, sc, 0, 0, 0); }
#pragma unroll
                for (int i = 0; i < 4; ++i) { const int t = 16 * mt + 4 * q + i, s_ = 16 * ms + c; Aimg[t * AI_LD + s_] = f2bf(s_ <= t ? sc[i] : 0.f); }
            }
            LBAR();
        }
        {
            const bf16x8 vfr = trfrag(L + HG_V, lane, w, 0);
            if (MODE == 3) {
                bf16x8 sfr[4];
#pragma unroll
                for (int ks = 0; ks < 4; ++ks) sfr[ks] = trfrag(L + HG_SIMG, lane, w, ks);
#pragma unroll
                for (int mt = 0; mt < 2; ++mt) { f32x4 oacc = (f32x4){0.f, 0.f, 0.f, 0.f};
                    { const bf16x8 a = *(const PG8_LAS bf16x8*)(Aimg + (16 * mt + c) * AI_LD + 8 * q); oacc = __builtin_amdgcn_mfma_f32_16x16x32_bf16(a, vfr, oacc, 0, 0, 0); }
#pragma unroll
                    for (int ks = 0; ks < 4; ++ks) { const bf16x8 a = *(const PG8_LAS bf16x8*)(L + HG_QT + rr16(lane, mt, ks)); oacc = __builtin_amdgcn_mfma_f32_16x16x32_bf16(a, sfr[ks], oacc, 0, 0, 0); }
#pragma unroll
                    for (int i = 0; i < 4; ++i) Obuf[(16 * mt + 4 * q + i) * OB_LD + 16 * w + c] = oacc[i]; }
            }
#pragma unroll
            for (int n = 0; n < 8; ++n) { const bf16x8 kfr = trfrag(L + HG_QH, lane, n, 0);
                Sacc[n] = __builtin_amdgcn_mfma_f32_16x16x32_bf16(vfr, kfr, Sacc[n], 0, 0, 0);
                const float en = etot[16 * n + c]; Sacc[n][0] *= en; Sacc[n][1] *= en; Sacc[n][2] *= en; Sacc[n][3] *= en; }
        }
        if (MODE == 3) {
            LBAR();
#pragma unroll
            for (int n = 0; n < 8; ++n) { u32x2 wv; wv.x = pg8::cvt_pk_bf16(Sacc[n][0], Sacc[n][1]); wv.y = pg8::cvt_pk_bf16(Sacc[n][2], Sacc[n][3]);
                *(PG8_LAS u32x2*)(L + HG_SIMG + off_b(16 * n + c, 2 * w + (q >> 1)) + 8 * (q & 1)) = wv; }
            const int v0 = cg * 8;
            float o[8];
            { const f32x4 a0 = *(const PG8_LAS f32x4*)(Obuf + t1 * OB_LD + v0), a1 = *(const PG8_LAS f32x4*)(Obuf + t1 * OB_LD + v0 + 4);
              o[0] = a0[0]; o[1] = a0[1]; o[2] = a0[2]; o[3] = a0[3]; o[4] = a1[0]; o[5] = a1[1]; o[6] = a1[2]; o[7] = a1[3]; }
            bf16_t* mp = mix + (size_t)row * DM + h * 128 + v0;
            if (!combine) { *(u32x4*)mp = pack8(o); }
            else {
                float pv[8]; unpack8(cmix, pv);
                float ss = 0.f;
#pragma unroll
                for (int e = 0; e < 8; ++e) { o[e] += pv[e]; ss += o[e] * o[e]; }
                ss += __int_as_float(__builtin_amdgcn_update_dpp(0, __float_as_int(ss), 0xB1, 0xF, 0xF, true)); ss += __int_as_float(__builtin_amdgcn_update_dpp(0, __float_as_int(ss), 0x4E, 0xF, 0xF, true));
                ss += __int_as_float(__builtin_amdgcn_update_dpp(0, __float_as_int(ss), 0x141, 0xF, 0xF, true)); ss += __int_as_float(__builtin_amdgcn_update_dpp(0, __float_as_int(ss), 0x140, 0xF, 0xF, true));
                const float rs = rsqrtf(ss * (1.0f / 128.0f) + EPSV);
                float gg[8]; unpack8(cgate, gg);
                const float gn[8] = {gn0[0], gn0[1], gn0[2], gn0[3], gn1[0], gn1[1], gn1[2], gn1[3]};
                float r[8];
#pragma unroll
                for (int e = 0; e < 8; ++e) r[e] = o[e] * rs * gn[e] * (gg[e] * sigmoidf_(gg[e]));
                *(u32x4*)mp = pack8(r);
            }
        }
    }
#undef HG_LOAD
    if (MODE == 1) {
        float* st = states + ((size_t)seq * 64 + j) * 16384;
#pragma unroll
        for (int n = 0; n < 8; ++n) *(f32x4*)(st + (16 * n + c) * 128 + 16 * w + 4 * q) = Sacc[n];
        if (ts == 31) { float* dp = (float*)(P.ws + OFF_HGD) + ((size_t)seq * 64 + j) * 128 + 8 * cgs;
            *(f32x4*)dp = (f32x4){sup2[0].x, sup2[0].y, sup2[1].x, sup2[1].y}; *(f32x4*)(dp + 4) = (f32x4){sup2[2].x, sup2[2].y, sup2[3].x, sup2[3].y}; }
    }
    __syncthreads();
}

constexpr int P1_KH = 0, P1_V = 16384, P1_ETOT = 32768, P1_LB = 33792, P1_SUP = 34304, P1_STRIDE = 34816;
__device__ __forceinline__ void hg_run1x2(const Params& P, int layer, int x0, int x1, unsigned char* shm) {
    typedef float f32x2 __attribute__((ext_vector_type(2)));
    const int tid = threadIdx.x, w = tid >> 6, lane = tid & 63, c = lane & 15, q = lane >> 4;
    const int ts = lane & 31, hb = lane >> 5, cgs = 2 * w + hb;
    PG8_LAS unsigned char* L = (PG8_LAS unsigned char*)shm;
    const bf16_t* p = (const bf16_t*)(P.ws + OFF_R1);
    float* states = (float*)(P.ws + OFF_R2);
    int seq[2], jj[2], bb[2], dd[2], colz[2], colv[2];
#pragma unroll
    for (int u = 0; u < 2; ++u) { const int x = u ? x1 : x0; seq[u] = x >> 6; jj[u] = x & 63; bb[u] = seq[u] >> 3; dd[u] = seq[u] & 1; const int h = (seq[u] >> 1) & 3;
        colz[u] = 512 * (1 + dd[u]) + h * 128 + 8 * cgs; colv[u] = 1536 + h * 128 + 8 * cgs;
        if (tid < 128) { ((PG8_LAS float*)(L + u * P1_STRIDE + P1_LB))[tid] = ((const float*)(P.ws + OFF_LB))[(layer * 2 + dd[u]) * 512 + h * 128 + tid]; ((PG8_LAS float*)(L + u * P1_STRIDE + P1_SUP))[tid] = 1.0f; } }
    f32x4 Sacc[2][8];
#pragma unroll
    for (int u = 0; u < 2; ++u) {
#pragma unroll
        for (int n = 0; n < 8; ++n) Sacc[u][n] = (f32x4){0.f, 0.f, 0.f, 0.f}; }
    __syncthreads();
    const f32x2 one2 = (f32x2){1.0f, 1.0f}, nl2e = (f32x2){-1.4426950408889634f, -1.4426950408889634f}, tiny2 = (f32x2){1e-30f, 1e-30f};
    u32x4 nz[2], nv[2];
#pragma unroll
    for (int u = 0; u < 2; ++u) { const bf16_t* pr = p + (size_t)hg_row(bb[u], dd[u], jj[u], ts) * INC; nz[u] = *(const u32x4*)(pr + colz[u]); nv[u] = *(const u32x4*)(pr + colv[u]); }
#pragma unroll 1
    for (int ch = 0; ch < 8; ++ch) {
        u32x4 cz[2], cv[2];
#pragma unroll
        for (int u = 0; u < 2; ++u) { cz[u] = nz[u]; cv[u] = nv[u]; }
        if (ch < 7) {
#pragma unroll
            for (int u = 0; u < 2; ++u) { const bf16_t* pr = p + (size_t)hg_row(bb[u], dd[u], jj[u], (ch + 1) * 32 + ts) * INC; nz[u] = *(const u32x4*)(pr + colz[u]); nv[u] = *(const u32x4*)(pr + colv[u]); } }
        u32x4 khp[2]; f32x2 tot2[2][4];
#pragma unroll
        for (int u = 0; u < 2; ++u) { float zf[8]; unpack8(cz[u], zf); float kh[8]; f32x2 g2u[4], kk2u[4];
#pragma unroll
            for (int e2 = 0; e2 < 4; ++e2) { const f32x2 nzz = (f32x2){zf[2 * e2], zf[2 * e2 + 1]} * nl2e;
                const f32x2 t = (f32x2){__builtin_amdgcn_exp2f(nzz.x), __builtin_amdgcn_exp2f(nzz.y)} + one2;
                const f32x2 inv = (f32x2){__builtin_amdgcn_rcpf(t.x), __builtin_amdgcn_rcpf(t.y)};
                const f32x2 lbp2 = *(const PG8_LAS f32x2*)(L + u * P1_STRIDE + P1_LB + (8 * cgs + 2 * e2) * 4); const f32x2 oml = one2 - lbp2;
                g2u[e2] = lbp2 + oml * inv; kk2u[e2] = oml - oml * inv; }
            { float s0 = g2u[0].x, s1 = g2u[0].y, s2 = g2u[1].x, s3 = g2u[1].y, s4 = g2u[2].x, s5 = g2u[2].y, s6 = g2u[3].x, s7 = g2u[3].y;
              scan32_prod8(s0, s1, s2, s3, s4, s5, s6, s7);
              g2u[0] = (f32x2){s0, s1}; g2u[1] = (f32x2){s2, s3}; g2u[2] = (f32x2){s4, s5}; g2u[3] = (f32x2){s6, s7}; }
#pragma unroll
            for (int e2 = 0; e2 < 4; ++e2) { tot2[u][e2] = g2u[e2];
                const f32x2 cm = __builtin_elementwise_max(g2u[e2], tiny2);
                const f32x2 k2 = kk2u[e2] * (f32x2){__builtin_amdgcn_rcpf(cm.x), __builtin_amdgcn_rcpf(cm.y)};
                kh[2 * e2] = k2.x; kh[2 * e2 + 1] = k2.y; }
            khp[u] = pack8(kh); }
        const int pb = ch & 1;
#pragma unroll
        for (int u = 0; u < 2; ++u) {
            PG8_LAS float* etot = (PG8_LAS float*)(L + u * P1_STRIDE + P1_ETOT + pb * 512);
            const unsigned ob = off_b(ts, cgs);
            *(PG8_LAS u32x4*)(L + u * P1_STRIDE + P1_KH + pb * 8192 + ob) = khp[u];
            *(PG8_LAS u32x4*)(L + u * P1_STRIDE + P1_V + pb * 8192 + ob) = cv[u];
            if (ts == 31) { const f32x4 e0 = (f32x4){tot2[u][0].x, tot2[u][0].y, tot2[u][1].x, tot2[u][1].y}, e1 = (f32x4){tot2[u][2].x, tot2[u][2].y, tot2[u][3].x, tot2[u][3].y};
                *(PG8_LAS f32x4*)(etot + 8 * cgs) = e0; *(PG8_LAS f32x4*)(etot + 8 * cgs + 4) = e1;
                PG8_LAS f32x4* sp = (PG8_LAS f32x4*)(L + u * P1_STRIDE + P1_SUP + 8 * cgs * 4); sp[0] = sp[0] * e0; sp[1] = sp[1] * e1; } }
        LBAR();
#pragma unroll
        for (int u = 0; u < 2; ++u) {
            PG8_LAS float* etot = (PG8_LAS float*)(L + u * P1_STRIDE + P1_ETOT + pb * 512);
            const bf16x8 vfr = trfrag(L + u * P1_STRIDE + P1_V + pb * 8192, lane, w, 0);
#pragma unroll
            for (int n = 0; n < 8; ++n) { const bf16x8 kfr = trfrag(L + u * P1_STRIDE + P1_KH + pb * 8192, lane, n, 0);
                Sacc[u][n] = __builtin_amdgcn_mfma_f32_16x16x32_bf16(vfr, kfr, Sacc[u][n], 0, 0, 0);
                const float en = etot[16 * n + c]; Sacc[u][n][0] *= en; Sacc[u][n][1] *= en; Sacc[u][n][2] *= en; Sacc[u][n][3] *= en; } }
    }
#pragma unroll
    for (int u = 0; u < 2; ++u) {
        float* st = states + ((size_t)seq[u] * 64 + jj[u]) * 16384;
#pragma unroll
        for (int n = 0; n < 8; ++n) *(f32x4*)(st + (16 * n + c) * 128 + 16 * w + 4 * q) = Sacc[u][n];
        if (ts == 31) { float* dp = (float*)(P.ws + OFF_HGD) + ((size_t)seq[u] * 64 + jj[u]) * 128 + 8 * cgs; const PG8_LAS f32x4* sp = (const PG8_LAS f32x4*)(L + u * P1_STRIDE + P1_SUP + 8 * cgs * 4);
            const f32x4 s0 = sp[0], s1 = sp[1]; *(f32x4*)dp = s0; *(f32x4*)(dp + 4) = s1; } }
    __syncthreads();
}

__device__ __forceinline__ float gelu_tanh(float x) { const float u = 0.7978845608028654f * (x + 0.044715f * x * x * x); const float e = __expf(2.0f * u); const float th = 1.0f - 2.0f * __builtin_amdgcn_rcpf(e + 1.0f); return 0.5f * x * (1.0f + th); }

template <int MODE  >
__device__ __forceinline__ void rg_item(const Params& P, int layer, int b, int ci, unsigned char* shm) {
    const int tid = threadIdx.x, w = tid >> 6, lane = tid & 63, c = lane & 15, q = lane >> 4, cg = lane & 7, tq = lane >> 3;
    PG8_LAS unsigned char* U = (PG8_LAS unsigned char*)shm + w * 16384;
    PG8_LAS unsigned char* Ut = U + 8192;
    const bf16_t* p = (const bf16_t*)(P.ws + OFF_R1);
    bf16_t* mix = (bf16_t*)(P.ws + OFF_R3);
    float* agg = (float*)(P.ws + OFF_RGAGG);
    const bool isctx = ci < 4;
    const int T0 = isctx ? ci * 64 : (ci - 4) * 64;
    const int rowbase = isctx ? NLAT + b * 256 : b * 16384;
    const int seglo = isctx ? 0 : T0, seghi = isctx ? 256 : T0 + 64;
    {
        u32x4 raw[11];
        const bf16_t* pc = p + (size_t)rowbase * INC + 2560 + 64 * w + 8 * cg;
#pragma unroll
        for (int x = 0; x < 11; ++x) { const int tok = T0 + 8 * tq - 2 + x; raw[x] = (tok >= seglo && tok < seghi) ? *(const u32x4*)(pc + (size_t)tok * INC) : (u32x4){0u, 0u, 0u, 0u}; }
        float cw[4][8], o[8][8];
        { const float* cwp = P.in[10] + (size_t)layer * 4 * 512 + 64 * w + 8 * cg;
#pragma unroll
          for (int jx = 0; jx < 4; ++jx) { const float4 a0 = *(const float4*)(cwp + jx * 512), a1 = *(const float4*)(cwp + jx * 512 + 4);
              cw[jx][0] = a0.x; cw[jx][1] = a0.y; cw[jx][2] = a0.z; cw[jx][3] = a0.w; cw[jx][4] = a1.x; cw[jx][5] = a1.y; cw[jx][6] = a1.z; cw[jx][7] = a1.w; }
          const float* cbp = P.in[11] + layer * 512 + 64 * w + 8 * cg; const float4 b0 = *(const float4*)cbp, b1 = *(const float4*)(cbp + 4);
#pragma unroll
          for (int k = 0; k < 8; ++k) { o[k][0] = b0.x; o[k][1] = b0.y; o[k][2] = b0.z; o[k][3] = b0.w; o[k][4] = b1.x; o[k][5] = b1.y; o[k][6] = b1.z; o[k][7] = b1.w; } }
#pragma unroll
        for (int x = 0; x < 11; ++x) { float f[8]; unpack8(raw[x], f);
#pragma unroll
            for (int jx = 0; jx < 4; ++jx) { const int k = x - jx; if (k >= 0 && k < 8) {
#pragma unroll
                for (int e = 0; e < 8; ++e) o[k][e] += cw[jx][e] * f[e]; } } }
#pragma unroll
        for (int k = 0; k < 8; ++k) { const int tau = 8 * tq + k; *(PG8_LAS u32x4*)(U + tau * 128 + ((cg ^ (tau & 7)) << 4)) = pack8(o[k]); }
#pragma unroll
        for (int e = 0; e < 8; ++e) { const int chn = 8 * cg + e; float vv[8];
#pragma unroll
            for (int k = 0; k < 8; ++k) vv[k] = o[k][e];
            *(PG8_LAS u32x4*)(Ut + chn * 128 + ((tq ^ (chn & 7)) << 4)) = pack8(vv); }
    }
    bf16x8 Af[4][2];
#pragma unroll
    for (int m = 0; m < 4; ++m)
#pragma unroll
        for (int kk = 0; kk < 2; ++kk) { const int tau = 16 * (c >> 2) + 4 * m + (c & 3); const int lc = 4 * kk + q; Af[m][kk] = *(const PG8_LAS bf16x8*)(U + tau * 128 + ((lc ^ (tau & 7)) << 4)); }
#pragma unroll
    for (int d = 0; d < 2; ++d) {
        const u32x4* wf = (const u32x4*)(P.ws + OFF_WF) + (size_t)((layer * 2 + d) * 8 + w) * 1024 + lane;
        const int csd = d == 0 ? ci : (isctx ? 3 - ci : 4 + (259 - ci));
        float* ag = agg + (size_t)((d * 2 + b) * 260 + csd) * 1024;
        u32x4 n_wa0, n_wa1, n_wx0, n_wx1; float n_ba, n_bx, n_lam, n_h0 = 0.f;
#define RG_LOAD(NT) do { const int ch_ = 64 * w + 16 * (NT) + c; \
            n_wa0 = wf[((0 * 4 + (NT)) * 2 + 0) * 64]; n_wa1 = wf[((0 * 4 + (NT)) * 2 + 1) * 64]; n_wx0 = wf[((1 * 4 + (NT)) * 2 + 0) * 64]; n_wx1 = wf[((1 * 4 + (NT)) * 2 + 1) * 64]; \
            n_ba = P.in[13][(layer * 2 + d) * 512 + ch_]; n_bx = P.in[15][(layer * 2 + d) * 512 + ch_]; n_lam = P.in[16][(layer * 2 + d) * 512 + ch_]; \
            if (MODE == 1) n_h0 = ag[ch_]; \
            } while (0)
        RG_LOAD(0);
#pragma unroll 1
        for (int nt = 0; nt < 4; ++nt) {
            const int chl = 16 * nt + c, ch = 64 * w + chl;
            const u32x4 wa0 = n_wa0, wa1 = n_wa1, wx0 = n_wx0, wx1 = n_wx1;
            const float bav = n_ba, bxv = n_bx, lam = n_lam;
            const float h0 = n_h0;
            if (nt < 3) RG_LOAD(nt + 1);
            const float c8 = -8.0f * log1pf(__expf(-lam));
            f32x4 ar[4], ax[4];
#pragma unroll
            for (int m = 0; m < 4; ++m) { ar[m] = (f32x4){0.f, 0.f, 0.f, 0.f}; ax[m] = (f32x4){0.f, 0.f, 0.f, 0.f};
                ar[m] = __builtin_amdgcn_mfma_f32_16x16x32_bf16(Af[m][0], __builtin_bit_cast(bf16x8, wa0), ar[m], 0, 0, 0); ar[m] = __builtin_amdgcn_mfma_f32_16x16x32_bf16(Af[m][1], __builtin_bit_cast(bf16x8, wa1), ar[m], 0, 0, 0);
                ax[m] = __builtin_amdgcn_mfma_f32_16x16x32_bf16(Af[m][0], __builtin_bit_cast(bf16x8, wx0), ax[m], 0, 0, 0); ax[m] = __builtin_amdgcn_mfma_f32_16x16x32_bf16(Af[m][1], __builtin_bit_cast(bf16x8, wx1), ax[m], 0, 0, 0); }
            float uf[16];
            { const u32x4 u0 = *(const PG8_LAS u32x4*)(Ut + chl * 128 + (((2 * q) ^ (chl & 7)) << 4)), u1 = *(const PG8_LAS u32x4*)(Ut + chl * 128 + (((2 * q + 1) ^ (chl & 7)) << 4));
              unpack8(u0, uf); unpack8(u1, uf + 8); }
            float av[16], hv[16];
            {
                typedef float f32x2 __attribute__((ext_vector_type(2)));
                const float nba = bav * -1.4426950408889634f, nbx = bxv * -1.4426950408889634f, c8l = c8 * 1.4426950408889634f;
                const f32x2 nba2 = (f32x2){nba, nba}, nbx2 = (f32x2){nbx, nbx}, one2 = (f32x2){1.0f, 1.0f}, c82 = (f32x2){c8l, c8l};
#pragma unroll
                for (int m = 0; m < 4; ++m)
#pragma unroll
                    for (int pr = 0; pr < 2; ++pr) { const int kp = 4 * m + 2 * pr;
                        const f32x2 na = (f32x2){ar[m][2 * pr], ar[m][2 * pr + 1]} + nba2, nx = (f32x2){ax[m][2 * pr], ax[m][2 * pr + 1]} + nbx2;
                        f32x2 t1 = (f32x2){__builtin_amdgcn_exp2f(na.x), __builtin_amdgcn_exp2f(na.y)} + one2, t2 = (f32x2){__builtin_amdgcn_exp2f(nx.x), __builtin_amdgcn_exp2f(nx.y)} + one2;
                        const f32x2 r = (f32x2){__builtin_amdgcn_rcpf(t1.x), __builtin_amdgcn_rcpf(t1.y)}, ig = (f32x2){__builtin_amdgcn_rcpf(t2.x), __builtin_amdgcn_rcpf(t2.y)};
                        const f32x2 la = r * c82; const f32x2 a = (f32x2){__builtin_amdgcn_exp2f(la.x), __builtin_amdgcn_exp2f(la.y)};
                        const f32x2 om = one2 - a * a;
                        const f32x2 mult = (f32x2){__builtin_amdgcn_sqrtf(om.x), __builtin_amdgcn_sqrtf(om.y)};
                        const f32x2 hh = mult * ig * (f32x2){uf[kp], uf[kp + 1]};
                        av[kp] = a.x; av[kp + 1] = a.y; hv[kp] = hh.x; hv[kp + 1] = hh.y; }
            }
            { float hl = 0.f, cp = 1.f;
#pragma unroll
              for (int kk2 = 0; kk2 < 16; ++kk2) { const int kp = d ? 15 - kk2 : kk2; hl = av[kp] * hl + hv[kp]; cp *= av[kp]; hv[kp] = hl; av[kp] = cp; } }
            const float Aq = d ? av[0] : av[15], Hq = d ? hv[0] : hv[15];
            const float A0 = __shfl(Aq, c), A1 = __shfl(Aq, c + 16), A2 = __shfl(Aq, c + 32), A3 = __shfl(Aq, c + 48);
            const float H0 = __shfl(Hq, c), H1 = __shfl(Hq, c + 16), H2 = __shfl(Hq, c + 32), H3 = __shfl(Hq, c + 48);
            if (MODE == 0) {
                if (q == 0) { float Pt, Ht;
                    if (d == 0) { Pt = (A0 * A1) * (A2 * A3); Ht = ((H0 * A1 + H1) * A2 + H2) * A3 + H3; }
                    else { Pt = (A0 * A1) * (A2 * A3); Ht = ((H3 * A2 + H2) * A1 + H1) * A0 + H0; }
                    ag[ch] = Pt; ag[512 + ch] = Ht; }
            } else {
                float hin = h0;
                if (d == 0) { if (q >= 1) hin = A0 * hin + H0; if (q >= 2) hin = A1 * hin + H1; if (q >= 3) hin = A2 * hin + H2; }
                else { if (q <= 2) hin = A3 * hin + H3; if (q <= 1) hin = A2 * hin + H2; if (q <= 0) hin = A1 * hin + H1; }
                PG8_LAS unsigned char* hp0 = U + chl * 128 + (((2 * q) ^ (chl & 7)) << 4); PG8_LAS unsigned char* hp1 = U + chl * 128 + (((2 * q + 1) ^ (chl & 7)) << 4);
                if (d == 0) {
#pragma unroll
                    for (int kp = 0; kp < 16; ++kp) hv[kp] = hv[kp] + av[kp] * hin;
                    *(PG8_LAS u32x4*)hp0 = pack8(hv); *(PG8_LAS u32x4*)hp1 = pack8(hv + 8);
                } else {
                    float hfw[16]; unpack8(*(const PG8_LAS u32x4*)hp0, hfw); unpack8(*(const PG8_LAS u32x4*)hp1, hfw + 8);
#pragma unroll
                    for (int kp = 0; kp < 16; ++kp) hv[kp] = hfw[kp] + (hv[kp] + av[kp] * hin);
                    *(PG8_LAS u32x4*)hp0 = pack8(hv); *(PG8_LAS u32x4*)hp1 = pack8(hv + 8);
                }
            }
        }
#undef RG_LOAD
    }
    if (MODE == 1) {
        u32x4 gva[8];
#pragma unroll
        for (int k = 0; k < 8; ++k) gva[k] = *(const u32x4*)(p + (size_t)(rowbase + T0 + 8 * tq + k) * INC + 3072 + 64 * w + 8 * cg);
#pragma unroll
        for (int half = 0; half < 2; ++half) {
            u32x4 gv[4];
#pragma unroll
            for (int k = 0; k < 4; ++k) gv[k] = gva[4 * half + k];
            float val[8][4];
#pragma unroll
            for (int e = 0; e < 8; ++e) { const int chn = 8 * cg + e; const u32x2 hvv = *(const PG8_LAS u32x2*)(U + chn * 128 + ((tq ^ (chn & 7)) << 4) + 8 * half);
                val[e][0] = __uint_as_float(hvv.x << 16); val[e][1] = __uint_as_float(hvv.x & 0xffff0000u); val[e][2] = __uint_as_float(hvv.y << 16); val[e][3] = __uint_as_float(hvv.y & 0xffff0000u); }
#pragma unroll
            for (int k = 0; k < 4; ++k) { float g[8], o[8]; unpack8(gv[k], g);
#pragma unroll
                for (int e = 0; e < 8; ++e) o[e] = val[e][k] * gelu_tanh(g[e]);
                *(u32x4*)(mix + (size_t)(rowbase + T0 + 8 * tq + 4 * half + k) * DM + 512 + 64 * w + 8 * cg) = pack8(o); }
        }
    }
}

__device__ __forceinline__ void phase_mix1(const Params& P, int layer, unsigned char* shm) {
#ifndef MK_REP
#define MK_REP 0
#endif
    for (int rep = 0; rep < ((MK_REP & 1) ? 2 : 1); ++rep)
    for (int it = blockIdx.x; it < 520; it += gridDim.x) rg_item<0>(P, layer, it / 260, it % 260, shm);
    __syncthreads();
    { const int xa = (blockIdx.x + 248) % gridDim.x;
      int x = xa;
      for (; x + (int)gridDim.x < 1024; x += 2 * gridDim.x) hg_run1x2(P, layer, x, x + gridDim.x, shm);
      for (; x < 1024; x += gridDim.x) { const int seq = x >> 6, j = x & 63; hg_run<1>(P, layer, seq >> 3, (seq >> 1) & 3, seq & 1, j, false, shm); } }
}
__device__ __forceinline__ void phase_mix2(const Params& P, unsigned char* shm) {
    const int tid = threadIdx.x;
    float* lagg = (float*)shm;
    for (int it = blockIdx.x; it < 16 + 512; it += gridDim.x) {
        if (it < 16) {
            const int db = it >> 2, cl = tid & 127, g = tid >> 7, cch = (it & 3) * 128 + cl;
            float* ag = (float*)(P.ws + OFF_RGAGG) + (size_t)db * 260 * 1024 + cch + (size_t)g * 65 * 1024;
            float Pg = 1.f, Hg = 0.f;
            { const float* agp = ag;
#pragma unroll 1
            for (int s0 = 0; s0 < 5; ++s0, agp += 13 * 1024) {
                float Pv[13], Hv[13];
#pragma unroll
                for (int u = 0; u < 13; ++u) { Pv[u] = agp[u * 1024]; Hv[u] = agp[u * 1024 + 512]; }
#pragma unroll
                for (int u = 0; u < 13; ++u) { Hg = Pv[u] * Hg + Hv[u]; Pg *= Pv[u]; }
            } }
            lagg[g * 128 + cl] = Pg; lagg[512 + g * 128 + cl] = Hg;
            __syncthreads();
            float h = 0.f;
            for (int gg = 0; gg < g; ++gg) h = lagg[gg * 128 + cl] * h + lagg[512 + gg * 128 + cl];
            { float* agp = ag;
#pragma unroll 1
            for (int s0 = 0; s0 < 5; ++s0, agp += 13 * 1024) {
                float Pv[13], Hv[13];
#pragma unroll
                for (int u = 0; u < 13; ++u) { Pv[u] = agp[u * 1024]; Hv[u] = agp[u * 1024 + 512]; }
#pragma unroll
                for (int u = 0; u < 13; ++u) { agp[u * 1024] = h; h = Pv[u] * h + Hv[u]; }
            } }
            __syncthreads();
        } else {
            const int x = it - 16; const int seq = x >> 5; const int e = (x & 31) * 512 + tid; const int k = e >> 7;
            float* st = (float*)(P.ws + OFF_R2) + (size_t)seq * 64 * 16384 + e; const float* dd = (const float*)(P.ws + OFF_HGD) + (size_t)seq * 64 * 128 + k;
            float S = 0.f;
            float Ln[16], Dn[16];
#pragma unroll
            for (int u = 0; u < 16; ++u) { Ln[u] = st[(size_t)u * 16384]; Dn[u] = dd[u * 128]; }
#pragma unroll 1
            for (int s0 = 0; s0 < 4; ++s0, st += 16 * 16384, dd += 16 * 128) {
                float Lv[16], Dv[16];
#pragma unroll
                for (int u = 0; u < 16; ++u) { Lv[u] = Ln[u]; Dv[u] = Dn[u]; }
                if (s0 < 3) {
#pragma unroll
                    for (int u = 0; u < 16; ++u) { Ln[u] = st[(size_t)(16 + u) * 16384]; Dn[u] = dd[(16 + u) * 128]; } }
#pragma unroll
                for (int u = 0; u < 16; ++u) { S = Dv[u] * S + Lv[u]; st[(size_t)u * 16384] = S; }
            }
        }
    }
}
__device__ __forceinline__ void phase_mix3(const Params& P, int layer, unsigned char* shm) {
    const bool wc = layer == 0;
    const int nrg = wc ? 520 : 512, nj = wc ? 65 : 64, nhg = 8 * nj;
    const int x0 = (blockIdx.x + 248) % gridDim.x;
    const bool rg_skip = wc && gridDim.x == 256 && x0 < 8;
    const int rg_first = (wc && gridDim.x == 256) ? (blockIdx.x < 8 ? (int)blockIdx.x : (int)blockIdx.x - 8) : (int)blockIdx.x;
    const int rg_stride = (wc && gridDim.x == 256) ? 248 : (int)gridDim.x;
    if (!rg_skip)
    for (int it = rg_first; it < nrg; it += rg_stride) { const int per = wc ? 260 : 256; const int b = it / per, ci = (it % per) + (wc ? 0 : 4); rg_item<1>(P, layer, b, ci, shm); }
    __syncthreads();
    for (int rep = 0; rep < ((MK_REP & 8) ? 2 : 1); ++rep)
    for (int x = (blockIdx.x + 248) % gridDim.x; x < nhg; x += gridDim.x) { const int bh = x / nj, j = (x % nj) + (wc ? 0 : 1); const int b = bh >> 2, h = bh & 3;
#pragma unroll 1
        for (int dir = 0; dir < 2; ++dir) hg_run<3>(P, layer, b, h, dir, (dir == 0 || j == 0) ? j : 65 - j, dir == 1, shm); }
}

template <class Epi>
__device__ __forceinline__ void phase_gemm(const bf16_t* A, const bf16_t* Bt, int M, int N, int K, const Epi& E, unsigned char* shm) {
    pg8::Gemm g; g.A = A; g.Bt = Bt; g.M = M; g.N = N; g.K = K;
    pg8::StaticOrder S; S.init(M, N, (int)gridDim.x, (int)blockIdx.x);
#ifndef MK_GEMM_ALIGN
#define MK_GEMM_ALIGN true
#endif
#ifndef MK_GEMM_SP2
#define MK_GEMM_SP2 true
#endif
    pg8::gemm_phase<Epi, pg8::StaticOrder, MK_GEMM_ALIGN, MK_GEMM_SP2>((PG8_LAS unsigned char*)shm, g, S, E);
}

template <int K>
__device__ __forceinline__ void ctx_gemm_small(const bf16_t* __restrict__ A, const bf16_t* __restrict__ Bt, bf16_t* __restrict__ Y, unsigned char* shm) {
    const int tid = threadIdx.x, w = tid >> 6, lane = tid & 63, c = lane & 15, q = lane >> 4;
    PG8_LAS float* red = (PG8_LAS float*)shm;
    constexpr int KW = K / 8;
    for (int job = blockIdx.x; job < 256; job += gridDim.x) {
        const int row0 = (job >> 4) * 32, col0 = (job & 15) * 64;
        f32x4 acc[2][4];
#pragma unroll
        for (int mt = 0; mt < 2; ++mt)
#pragma unroll
            for (int nt = 0; nt < 4; ++nt) acc[mt][nt] = (f32x4){0.f, 0.f, 0.f, 0.f};
        const bf16_t* ap = A + (size_t)(row0 + c) * K + w * KW + 8 * q;
        const bf16_t* bp = Bt + (size_t)(col0 + c) * K + w * KW + 8 * q;
#pragma unroll 2
        for (int ks = 0; ks < KW / 32; ++ks) {
            bf16x8 a[2], b[4];
#pragma unroll
            for (int mt = 0; mt < 2; ++mt) a[mt] = *(const bf16x8*)(ap + (size_t)(16 * mt) * K + 32 * ks);
#pragma unroll
            for (int nt = 0; nt < 4; ++nt) b[nt] = *(const bf16x8*)(bp + (size_t)(16 * nt) * K + 32 * ks);
#pragma unroll
            for (int mt = 0; mt < 2; ++mt)
#pragma unroll
                for (int nt = 0; nt < 4; ++nt) acc[mt][nt] = __builtin_amdgcn_mfma_f32_16x16x32_bf16(a[mt], b[nt], acc[mt][nt], 0, 0, 0);
        }
#pragma unroll
        for (int mt = 0; mt < 2; ++mt)
#pragma unroll
            for (int nt = 0; nt < 4; ++nt)
#pragma unroll
                for (int i = 0; i < 4; ++i) red[w * 2048 + (16 * mt + 4 * q + i) * 64 + 16 * nt + c] = acc[mt][nt][i];
        __syncthreads();
        { const int idx = tid * 4, r = idx >> 6, cc = idx & 63;
          f32x4 sum = (f32x4){0.f, 0.f, 0.f, 0.f};
#pragma unroll
          for (int ww = 0; ww < 8; ++ww) sum += *(const PG8_LAS f32x4*)(red + ww * 2048 + idx);
          u32x2 o; o.x = pg8::cvt_pk_bf16(sum[0], sum[1]); o.y = pg8::cvt_pk_bf16(sum[2], sum[3]);
          *(u32x2*)(Y + (size_t)(row0 + r) * 1024 + col0 + cc) = o; }
        __syncthreads();
    }
}

#define XB_TMO      128
#define XB_XCNT(j)  (256  + 64 * (j))
#define XB_XSUB(j)  (1280 + 64 * (j))
#define XB_XGEN(j)  (2304 + 64 * (j))
#define XB_TOP      3328
#define XB_TOPGEN   3392
#define XCD_BAR_WORDS 3456
#define XB_SPIN_CAP (1u << 18)
#define XB_LAS __attribute__((address_space(3)))

__device__ __forceinline__ unsigned xb_ld(unsigned* p)              { return __hip_atomic_load(p, __ATOMIC_RELAXED, __HIP_MEMORY_SCOPE_AGENT); }
__device__ __forceinline__ unsigned xb_add(unsigned* p, unsigned v) { return __hip_atomic_fetch_add(p, v, __ATOMIC_RELAXED, __HIP_MEMORY_SCOPE_AGENT); }
__device__ __forceinline__ unsigned xb_xcc_id() { return (unsigned)__builtin_amdgcn_s_getreg((3 << 11) | 20) & 0xFu; }
#define XB_SPIN(cond, bar) do { unsigned _sp = 0; while (cond) { __builtin_amdgcn_s_sleep(1); \
    if ((++_sp & 255u) == 0u) { if (xb_ld(&(bar)[XB_TMO])) break; if (_sp > XB_SPIN_CAP) { atomicAdd(&(bar)[XB_TMO], 1u); break; } } } } while (0)

struct XcdBarrier {
    unsigned* bar; unsigned x;
    volatile XB_LAS unsigned* st;
};

__device__ __forceinline__ XcdBarrier xcd_barrier_post(unsigned* bar, volatile XB_LAS unsigned* st) {
    XcdBarrier b; b.bar = bar; b.x = xb_xcc_id(); b.st = st;
    if (threadIdx.x == 0) (void)xb_add(&bar[XB_XCNT(b.x)], 1u);
    return b;
}
__device__ __forceinline__ void xcd_barrier_complete(unsigned* bar, unsigned x, unsigned& nloc, unsigned& nx) {
    const unsigned G = gridDim.x * gridDim.y * gridDim.z;
    unsigned sum, cnt, mine, sp = 0u;
    for (;;) {
        sum = 0u; cnt = 0u; mine = 0u;
#pragma unroll
        for (unsigned j = 0; j < 16; ++j) { const unsigned c = xb_ld(&bar[XB_XCNT(j)]); sum += c; cnt += (c > 0u) ? 1u : 0u; mine = (j == x) ? c : mine; }
        if (sum == G) break;
        __builtin_amdgcn_s_sleep(1);
        if ((++sp & 255u) == 0u) { if (xb_ld(&bar[XB_TMO])) break; if (sp > XB_SPIN_CAP) { atomicAdd(&bar[XB_TMO], 1u); break; } }
    }
    nloc = mine > 0u ? mine : 1u; nx = cnt > 0u ? cnt : 1u;
}

__device__ __forceinline__ void xcd_barrier(const XcdBarrier& b) {
    asm volatile("s_waitcnt vmcnt(0)" ::: "memory");
    __syncthreads();
    if (threadIdx.x == 0) {
        unsigned* bar = b.bar;
        __builtin_amdgcn_s_waitcnt(0);
        unsigned nloc = b.st[0], nx = b.st[1];
        if (nloc == 0u) { xcd_barrier_complete(bar, b.x, nloc, nx); b.st[0] = nloc; b.st[1] = nx; }
        const unsigned old = xb_add(&bar[XB_XSUB(b.x)], 1u);
        const unsigned gen = old / nloc;
        if (old + 1u == (gen + 1u) * nloc) {
            __builtin_amdgcn_fence(__ATOMIC_RELEASE, "agent");
            asm volatile("s_waitcnt vmcnt(0)" ::: "memory");
            const unsigned og = xb_add(&bar[XB_TOP], 1u);
            const unsigned tg = og / nx;
            if (og + 1u == (tg + 1u) * nx) xb_add(&bar[XB_TOPGEN], 1u);
            else XB_SPIN(xb_ld(&bar[XB_TOPGEN]) == tg, bar);
            __builtin_amdgcn_fence(__ATOMIC_ACQUIRE, "agent");
            xb_add(&bar[XB_XGEN(b.x)], 1u);
            asm volatile("s_waitcnt vmcnt(0)" ::: "memory");
        } else {
            XB_SPIN(xb_ld(&bar[XB_XGEN(b.x)]) == gen, bar);
            __builtin_amdgcn_fence(__ATOMIC_ACQUIRE, "agent");
            asm volatile("s_waitcnt vmcnt(0)" ::: "memory");
        }
    }
    __syncthreads();
}

constexpr int N_PHASES = 20;
template <int ph> __device__ __forceinline__ void run_phase(const Params& P, unsigned char* shm) {
    unsigned char* ws = P.ws;
    const float* mods = (const float*)(ws + OFF_MODS);
    bf16_t* hA = (bf16_t*)(ws + OFF_R2); bf16_t* pbuf = (bf16_t*)(ws + OFF_R1); bf16_t* mix = (bf16_t*)(ws + OFF_R3); bf16_t* ybuf = (bf16_t*)(ws + OFF_R2); bf16_t* xb = (bf16_t*)(ws + OFF_R4); bf16_t* hid = (bf16_t*)(ws + OFF_R1);
    float* xctx = (float*)(ws + OFF_XCTX);
    if constexpr (ph == 0) { phase_prep(P, shm); return; }
    else if constexpr (ph == 1) {
        RowOp R; R.xs_lat = P.in[0]; R.xs_ctx = P.in[2]; R.xd_lat = P.out; R.xd_ctx = xctx; R.xs_lat_b = (const bf16_t*)(ws + OFF_R4); R.xd_lat_b = (bf16_t*)(ws + OFF_R4); R.y = nullptr; R.yw = nullptr; R.mods_y = nullptr; R.gate_idx = 0;
        R.hdst = hA; R.hw = P.in[6]; R.mods_h = mods; R.shift_idx = 0; R.scale_idx = 1; R.nrows = NROWS;
        phase_rowop<false, false>(R, shm); return;
    } else {
    constexpr int layer = (ph - 2) / 9, sub = (ph - 2) % 9;
    constexpr bool last = layer == 1;
    constexpr int Mrows = last ? NLAT : NROWS;
    const float* ng = P.in[6] + (size_t)layer * 4 * 1024;
    const float* lmods = mods + (size_t)layer * 3 * 6144;
    if constexpr (sub == 0) { pg8::EpiBf16<0> E; E.O = pbuf; E.ldc = INC; E.bias = nullptr; E.split_cols = 0; E.split_stride = 0;
              phase_gemm(hA, (const bf16_t*)(ws + OFF_WIN + layer * SZ_WIN), NROWS, INC, DM, E, shm); }
    else if constexpr (sub == 1) { phase_mix1(P, layer, shm); }
    else if constexpr (sub == 2) { phase_mix2(P, shm); }
    else if constexpr (sub == 3) { phase_mix3(P, layer, shm); }
    else if constexpr (sub == 4) { { pg8::EpiBf16<0> E; E.O = ybuf; E.ldc = DM; E.bias = nullptr; E.split_cols = 0; E.split_stride = 0;
              phase_gemm(mix, (const bf16_t*)(ws + OFF_WOUT + layer * SZ_WOUT), NLAT, DM, DM, E, shm);
              if (!last) ctx_gemm_small<DM>(mix + (size_t)NLAT * DM, (const bf16_t*)(ws + OFF_WOUT + layer * SZ_WOUT), ybuf + (size_t)NLAT * DM, shm); } }
    else if constexpr (sub == 5) { { RowOp R; R.xs_lat = P.in[0]; R.xs_lat_b = xb; R.xs_ctx = layer == 0 ? P.in[2] : xctx; R.xd_lat = P.out; R.xd_lat_b = xb; R.xd_ctx = xctx;
              R.y = ybuf; R.yw = ng + 1024; R.mods_y = lmods; R.gate_idx = 2;
              R.hdst = hA; R.hw = ng + 2048; R.mods_h = lmods; R.shift_idx = 3; R.scale_idx = 4; R.nrows = Mrows;
              phase_rowop<(layer != 0), true>(R, shm); } }
    else if constexpr (sub == 6) { { EpiSwiglu E; E.O = hid; E.ldc = DFF;
              phase_gemm(hA, (const bf16_t*)(ws + OFF_WGU + layer * SZ_WGU), Mrows, NGU, DM, E, shm); } }
    else if constexpr (sub == 7) { { bf16_t* ybuf2 = mix; pg8::EpiBf16<0> E; E.O = ybuf2; E.ldc = DM; E.bias = nullptr; E.split_cols = 0; E.split_stride = 0;
              phase_gemm(hid, (const bf16_t*)(ws + OFF_WDN + layer * SZ_WDN), NLAT, DM, DFF, E, shm);
              if (!last) ctx_gemm_small<DFF>(hid + (size_t)NLAT * DFF, (const bf16_t*)(ws + OFF_WDN + layer * SZ_WDN), ybuf2 + (size_t)NLAT * DM, shm); } }
    else if constexpr (sub == 8) { { RowOp R; R.xs_lat = P.in[0]; R.xs_lat_b = xb; R.xs_ctx = xctx; R.xd_lat = P.out; R.xd_lat_b = xb; R.xd_ctx = xctx;
              R.y = mix; R.yw = ng + 3072; R.mods_y = lmods; R.gate_idx = 5;
              if (!last) { R.hdst = hA; R.hw = P.in[6] + (size_t)(layer + 1) * 4 * 1024; R.mods_h = mods + (size_t)(layer + 1) * 3 * 6144; R.shift_idx = 0; R.scale_idx = 1; }
              else { R.hdst = nullptr; R.hw = nullptr; R.mods_h = nullptr; R.shift_idx = 0; R.scale_idx = 0; }
              R.nrows = Mrows;
              phase_rowop<true, !last>(R, shm); } }
    }
}

__global__ __launch_bounds__(512, 2) void mk_fwd(Params P, int ph_lo, int ph_hi) {
    extern __shared__ __attribute__((aligned(16))) unsigned char shm[];
    __shared__ uint4 xb_words;
    cg::grid_group grid = cg::this_grid();
    if (ph_hi < 0) grid.sync();
    if (threadIdx.x == 0) xb_words = make_uint4(0u, 0u, 0u, 0u);
    __syncthreads();
    XcdBarrier xb = xcd_barrier_post((unsigned*)(P.ws + OFF_BAR), (volatile XB_LAS unsigned*)&xb_words);
#ifndef MK_REPEAT_MASK
#define MK_REPEAT_MASK 0u
#endif
#define MK_PHASE(k) if (ph_lo <= (k) && (k) < ph_hi) { if ((k) > ph_lo) xcd_barrier(xb); run_phase<(k)>(P, shm); if constexpr ((MK_REPEAT_MASK >> (k)) & 1u) { xcd_barrier(xb); run_phase<(k)>(P, shm); } }
    MK_PHASE(0) MK_PHASE(1) MK_PHASE(2) MK_PHASE(3) MK_PHASE(4) MK_PHASE(5) MK_PHASE(6) MK_PHASE(7) MK_PHASE(8) MK_PHASE(9)
    MK_PHASE(10) MK_PHASE(11) MK_PHASE(12) MK_PHASE(13) MK_PHASE(14) MK_PHASE(15) MK_PHASE(16) MK_PHASE(17) MK_PHASE(18) MK_PHASE(19)
#undef MK_PHASE
    xcd_barrier(xb);
}

extern "C" void kernel_launch(void* const* d_in, const int* in_sizes, int n_in, void* d_out, int out_size, void* d_ws, size_t ws_size, hipStream_t stream) {
    static int grid = 0;
    if (grid == 0) {
        int dev = 0, cus = 0, per_cu = 0;
        hipGetDevice(&dev);
        hipDeviceGetAttribute(&cus, hipDeviceAttributeMultiprocessorCount, dev);
        hipFuncSetAttribute((const void*)mk_fwd, hipFuncAttributeMaxDynamicSharedMemorySize, LDS_BYTES);
        hipOccupancyMaxActiveBlocksPerMultiprocessor(&per_cu, (const void*)mk_fwd, 512, LDS_BYTES);
        if (per_cu < 1) per_cu = 1;
        grid = cus * 1;
        if (n_in != 21 || ws_size < WS_END) fprintf(stderr, "kernel_launch: unexpected n_in %d or ws_size %zu (need %zu)\n", n_in, ws_size, (size_t)WS_END);
        (void)hipGetLastError();
    }
    Params P{};
    for (int i = 0; i < 21; ++i) P.in[i] = (const float*)d_in[i];
    P.out = (float*)d_out; P.ws = (unsigned char*)d_ws;
    (void)hipMemsetAsync((unsigned char*)d_ws + OFF_BAR, 0, 16384, stream);
#if MK_SINGLE
    int lo = 0, hi = N_PHASES;
    void* args[] = {&P, &lo, &hi};
    hipError_t e = hipLaunchCooperativeKernel((const void*)mk_fwd, dim3(grid), dim3(512), args, LDS_BYTES, stream);
    if (e != hipSuccess) fprintf(stderr, "cooperative launch failed: %s (grid %d)\n", hipGetErrorString(e), grid);
#else
    for (int ph = 0; ph < N_PHASES; ++ph) hipLaunchKernelGGL(mk_fwd, dim3(grid), dim3(512), LDS_BYTES, stream, P, ph, ph + 1);
#endif
}
```
